# Optimizing an MI355X kernel written in HIP

```python
import math
import jax, jax.numpy as jnp
from jax import lax
import numpy as np

D_MODEL = 1024
BATCH = 16
SEQ = 2048
DEPTH = 2
DEC_BATCH = 128
DEC_SEQ = 1
PAST_LEN = 16384
PAGE_SIZE = 128

N_MIXERS = 2
N_ATTN_LAYERS = (DEPTH + 1) // 2
N_RET_LAYERS = DEPTH // 2
ATT_HEADS = 32
ATT_KV_HEADS = 4
ATT_GROUP = ATT_HEADS // ATT_KV_HEADS
ATT_HEAD_DIM = 64
ATT_WIDTH = ATT_HEADS * ATT_HEAD_DIM
ATT_KV_WIDTH = ATT_KV_HEADS * ATT_HEAD_DIM
ATT_IN = ATT_WIDTH + 2 * ATT_KV_WIDTH + ATT_WIDTH
WINDOW = 128
NUM_BUCKETS = 32
MAX_DISTANCE = 128
RET_HEADS = 4
RET_QK_DIM = 256
RET_V_DIM = 512
RET_QK_WIDTH = RET_HEADS * RET_QK_DIM
RET_WIDTH = RET_HEADS * RET_V_DIM
RET_IN = 2 * RET_QK_WIDTH + 2 * RET_WIDTH
RET_CHUNK = 128
ROPE_BASE = 10000.0
EPS = 1e-6
NEG = -1e30

kernel_name = 'hybrid_swa_sink_retention_step'


def _rmsnorm(x, g):
    xf = x.astype(jnp.float32)
    y = xf * lax.rsqrt(jnp.mean(xf * xf, axis=-1, keepdims=True) + EPS) * g.astype(jnp.float32)
    return y.astype(x.dtype)


def _t5_bucket(rel):
    n = jnp.maximum(rel, 0)
    max_exact = NUM_BUCKETS // 2
    nf = jnp.maximum(n, 1).astype(jnp.float32)
    large = max_exact + (jnp.log(nf / max_exact) / math.log(MAX_DISTANCE / max_exact)
                         * (NUM_BUCKETS - max_exact)).astype(jnp.int32)
    large = jnp.minimum(large, NUM_BUCKETS - 1)
    return jnp.where(n < max_exact, n, large)


def _gated_out(o, g, w_out):
    y = jax.nn.silu(g.astype(jnp.float32)) * o.astype(jnp.float32)
    return y.astype(w_out.dtype) @ w_out


def _attn_project(h, w_in):
    B, T, _ = h.shape
    proj = h @ w_in
    q, k, v, g = jnp.split(proj, [ATT_WIDTH, ATT_WIDTH + ATT_KV_WIDTH, ATT_WIDTH + 2 * ATT_KV_WIDTH], axis=-1)
    q = q.reshape(B, T, ATT_KV_HEADS, ATT_GROUP, ATT_HEAD_DIM)
    k = k.reshape(B, T, ATT_KV_HEADS, ATT_HEAD_DIM)
    v = v.reshape(B, T, ATT_KV_HEADS, ATT_HEAD_DIM)
    return q, k, v, g


def _swa_attend(q, k, v, q_pos, k_pos, rel_bias, sink):
    Tq, Tk = q.shape[1], k.shape[1]
    logits = jnp.einsum('bqkgd,bskd->bkgqs', q.astype(jnp.float32), k.astype(jnp.float32)) * (ATT_HEAD_DIM ** -0.5)
    rel = q_pos[:, None] - k_pos[None, :]
    bias = jnp.transpose(rel_bias.astype(jnp.float32)[_t5_bucket(rel)], (2, 0, 1))
    bias = bias.reshape(ATT_KV_HEADS, ATT_GROUP, Tq, Tk)
    valid = (k_pos[None, :] >= 0) & (rel >= 0) & (rel < WINDOW)
    logits = jnp.where(valid, logits + bias, NEG)
    s = sink.astype(jnp.float32).reshape(ATT_KV_HEADS, ATT_GROUP, 1, 1)
    m = jnp.maximum(jnp.max(logits, axis=-1, keepdims=True), s)
    p = jnp.exp(logits - m)
    w = p / (jnp.sum(p, axis=-1, keepdims=True) + jnp.exp(s - m))
    return jnp.einsum('bkgqs,bskd->bqkgd', w, v.astype(jnp.float32))


def _attn_prompt(h, w_in, sink, w_out, rel_bias):
    B, S, _ = h.shape
    q, k, v, g = _attn_project(h, w_in)
    nblk = S // WINDOW
    pad = jnp.zeros((B, WINDOW, ATT_KV_HEADS, ATT_HEAD_DIM), k.dtype)
    k_ext = jnp.concatenate([pad, k], axis=1).reshape(B, nblk + 1, WINDOW, ATT_KV_HEADS, ATT_HEAD_DIM)
    v_ext = jnp.concatenate([pad, v], axis=1).reshape(B, nblk + 1, WINDOW, ATT_KV_HEADS, ATT_HEAD_DIM)
    k_prev, k_cur = jnp.moveaxis(k_ext[:, :-1], 1, 0), jnp.moveaxis(k_ext[:, 1:], 1, 0)
    v_prev, v_cur = jnp.moveaxis(v_ext[:, :-1], 1, 0), jnp.moveaxis(v_ext[:, 1:], 1, 0)
    q_blk = jnp.moveaxis(q.reshape(B, nblk, WINDOW, ATT_KV_HEADS, ATT_GROUP, ATT_HEAD_DIM), 1, 0)
    starts = jnp.arange(nblk, dtype=jnp.int32) * WINDOW

    def one_block(args):
        qb, kp, kc, vp, vc, s0 = args
        kb = jnp.concatenate([kp, kc], axis=1)
        vb = jnp.concatenate([vp, vc], axis=1)
        q_pos = s0 + jnp.arange(WINDOW, dtype=jnp.int32)
        k_pos = s0 - WINDOW + jnp.arange(2 * WINDOW, dtype=jnp.int32)
        return _swa_attend(qb, kb, vb, q_pos, k_pos, rel_bias, sink)

    o = lax.map(one_block, (q_blk, k_prev, k_cur, v_prev, v_cur, starts))
    o = jnp.moveaxis(o, 0, 1).reshape(B, S, ATT_WIDTH)
    y = _gated_out(o, g, w_out)
    return y, k[:, S - WINDOW:], v[:, S - WINDOW:]


def _attn_sample(h, ck, cv, w_in, sink, w_out, rel_bias):
    B, T, _ = h.shape
    q, k, v, g = _attn_project(h, w_in)
    kb = jnp.concatenate([ck.astype(k.dtype), k], axis=1)
    vb = jnp.concatenate([cv.astype(v.dtype), v], axis=1)
    q_pos = PAST_LEN + jnp.arange(T, dtype=jnp.int32)
    k_pos = PAST_LEN - WINDOW + jnp.arange(WINDOW + T, dtype=jnp.int32)
    o = _swa_attend(q, kb, vb, q_pos, k_pos, rel_bias, sink).reshape(B, T, ATT_WIDTH)
    y = _gated_out(o, g, w_out)
    return y, kb[:, T:].astype(ck.dtype), vb[:, T:].astype(cv.dtype)


def _log_gamma():
    return jnp.log1p(-jnp.exp2(-5.0 - jnp.arange(RET_HEADS, dtype=jnp.float32)))


def _rotary(x, pos):
    half = RET_QK_DIM // 2
    inv = ROPE_BASE ** (-jnp.arange(half, dtype=jnp.float32) / half)
    ang = pos.astype(jnp.float32)[:, None] * inv[None, :]
    cos = jnp.cos(ang)[None, :, None, :]
    sin = jnp.sin(ang)[None, :, None, :]
    x1, x2 = x[..., :half], x[..., half:]
    return jnp.concatenate([x1 * cos - x2 * sin, x1 * sin + x2 * cos], axis=-1)


def _ret_project(h, w_in, pos):
    B, T, _ = h.shape
    proj = h @ w_in
    q, k, v, g = jnp.split(proj, [RET_QK_WIDTH, 2 * RET_QK_WIDTH, 2 * RET_QK_WIDTH + RET_WIDTH], axis=-1)
    q = _rotary(q.reshape(B, T, RET_HEADS, RET_QK_DIM).astype(jnp.float32), pos)
    k = _rotary(k.reshape(B, T, RET_HEADS, RET_QK_DIM).astype(jnp.float32), pos) * (RET_QK_DIM ** -0.5)
    v = v.reshape(B, T, RET_HEADS, RET_V_DIM).astype(jnp.float32)
    return q, k, v, g


def _retention_chunk(q, k, v, R, log_gamma):
    C = q.shape[1]
    idx = jnp.arange(C, dtype=jnp.float32)
    diff = idx[:, None] - idx[None, :]
    decay = jnp.where(diff >= 0, jnp.exp(jnp.maximum(diff, 0.0)[None] * log_gamma[:, None, None]), 0.0)
    scores = jnp.einsum('bqhd,bshd->bhqs', q, k) * decay
    o = jnp.einsum('bhqs,bshv->bqhv', scores, v)
    cross = jnp.exp((idx[:, None] + 1.0) * log_gamma[None, :])
    o = o + jnp.einsum('bqhd,bhdv->bqhv', q, R) * cross[None, :, :, None]
    k_dec = k * jnp.exp((C - 1.0 - idx)[:, None] * log_gamma[None, :])[None, :, :, None]
    R_new = jnp.exp(C * log_gamma)[None, :, None, None] * R + jnp.einsum('bshd,bshv->bhdv', k_dec, v)
    return o, R_new


def _ret_output(o, g, w_out):
    B, T = o.shape[0], o.shape[1]
    mu = jnp.mean(o, axis=-1, keepdims=True)
    var = jnp.mean(jnp.square(o - mu), axis=-1, keepdims=True)
    o = ((o - mu) * lax.rsqrt(var + EPS)).reshape(B, T, RET_WIDTH)
    return _gated_out(o, g, w_out)


def _ret_prompt(h, w_in, w_out):
    B, S, _ = h.shape
    lg = _log_gamma()
    q, k, v, g = _ret_project(h, w_in, jnp.arange(S, dtype=jnp.int32))
    nch = S // RET_CHUNK

    def to_chunks(t):
        return jnp.moveaxis(t.reshape(B, nch, RET_CHUNK, *t.shape[2:]), 1, 0)

    def step(R, xs):
        qc, kc, vc = xs
        o, R_new = _retention_chunk(qc, kc, vc, R, lg)
        return R_new, o

    R0 = jnp.zeros((B, RET_HEADS, RET_QK_DIM, RET_V_DIM), jnp.float32)
    R_fin, o = lax.scan(step, R0, (to_chunks(q), to_chunks(k), to_chunks(v)))
    o = jnp.moveaxis(o, 0, 1).reshape(B, S, RET_HEADS, RET_V_DIM)
    return _ret_output(o, g, w_out), R_fin.astype(h.dtype)


def _ret_sample(h, state, w_in, w_out):
    T = h.shape[1]
    lg = _log_gamma()
    q, k, v, g = _ret_project(h, w_in, PAST_LEN + jnp.arange(T, dtype=jnp.int32))
    o, R_new = _retention_chunk(q, k, v, state.astype(jnp.float32), lg)
    return _ret_output(o, g, w_out), R_new.astype(state.dtype)


def setup_inputs(seed: int = 0) -> dict:
    key = jax.random.key(seed)
    ks = jax.random.split(key, 14)
    f32 = jnp.float32
    x_prompt = jax.random.normal(ks[0], (BATCH, SEQ, D_MODEL), f32)
    x_sample = jax.random.normal(ks[1], (DEC_BATCH, DEC_SEQ, D_MODEL), f32)
    cache_swa_k = jax.random.normal(ks[2], (N_ATTN_LAYERS, DEC_BATCH, WINDOW, ATT_KV_HEADS, ATT_HEAD_DIM), f32)
    cache_swa_v = jax.random.normal(ks[3], (N_ATTN_LAYERS, DEC_BATCH, WINDOW, ATT_KV_HEADS, ATT_HEAD_DIM), f32)
    state_ret = 0.5 * jax.random.normal(ks[4], (N_RET_LAYERS, DEC_BATCH, RET_HEADS, RET_QK_DIM, RET_V_DIM), f32)
    norm_g = 1.0 + 0.02 * jax.random.normal(ks[5], (DEPTH, D_MODEL), f32)
    final_norm_g = 1.0 + 0.02 * jax.random.normal(ks[6], (D_MODEL,), f32)
    rel_bias = 0.5 * jax.random.normal(ks[7], (NUM_BUCKETS, ATT_HEADS), f32)
    w_in_attn = jax.random.normal(ks[8], (N_ATTN_LAYERS, D_MODEL, ATT_IN), f32) * D_MODEL ** -0.5
    attn_sinks = 0.5 * jax.random.normal(ks[9], (N_ATTN_LAYERS, ATT_HEADS), f32)
    w_out_attn = jax.random.normal(ks[10], (N_ATTN_LAYERS, ATT_WIDTH, D_MODEL), f32) * ATT_WIDTH ** -0.5
    w_in_ret = jax.random.normal(ks[11], (N_RET_LAYERS, D_MODEL, RET_IN), f32) * D_MODEL ** -0.5
    w_out_ret = jax.random.normal(ks[12], (N_RET_LAYERS, RET_WIDTH, D_MODEL), f32) * RET_WIDTH ** -0.5
    return {'x_prompt': x_prompt, 'x_sample': x_sample,
            'cache_swa_k': cache_swa_k, 'cache_swa_v': cache_swa_v, 'state_ret': state_ret,
            'norm_g': norm_g, 'final_norm_g': final_norm_g, 'rel_bias': rel_bias,
            'w_in_attn': w_in_attn, 'attn_sinks': attn_sinks, 'w_out_attn': w_out_attn,
            'w_in_ret': w_in_ret, 'w_out_ret': w_out_ret}


def reference(x_prompt, x_sample, cache_swa_k, cache_swa_v, state_ret, norm_g, final_norm_g, rel_bias,
              w_in_attn, attn_sinks, w_out_attn, w_in_ret, w_out_ret):
    xp, xs = x_prompt, x_sample
    kp_l, vp_l, rp_l, ks_l, vs_l, rs_l = [], [], [], [], [], []
    for i in range(DEPTH):
        hp = _rmsnorm(xp, norm_g[i])
        hs = _rmsnorm(xs, norm_g[i])
        j = i // N_MIXERS
        if i % N_MIXERS == 0:
            yp, kp, vp = _attn_prompt(hp, w_in_attn[j], attn_sinks[j], w_out_attn[j], rel_bias)
            ys, kn, vn = _attn_sample(hs, cache_swa_k[j], cache_swa_v[j], w_in_attn[j], attn_sinks[j],
                                      w_out_attn[j], rel_bias)
            kp_l.append(kp); vp_l.append(vp); ks_l.append(kn); vs_l.append(vn)
        else:
            yp, rp = _ret_prompt(hp, w_in_ret[j], w_out_ret[j])
            ys, rn = _ret_sample(hs, state_ret[j], w_in_ret[j], w_out_ret[j])
            rp_l.append(rp); rs_l.append(rn)
        xp = xp + yp.astype(xp.dtype)
        xs = xs + ys.astype(xs.dtype)
    y_prompt = _rmsnorm(xp, final_norm_g)
    y_sample = _rmsnorm(xs, final_norm_g)
    return (y_prompt, y_sample, jnp.stack(kp_l), jnp.stack(vp_l), jnp.stack(rp_l),
            jnp.stack(ks_l), jnp.stack(vs_l), jnp.stack(rs_l))
```

```cpp
#include <hip/hip_runtime.h>
#include <hip/hip_cooperative_groups.h>
#include <hip/hip_bf16.h>
#include <cstdio>
#include <cstdint>
#include <cmath>
namespace cg = cooperative_groups;

namespace pg8 {
#define PG8_LAS __attribute__((address_space(3)))
typedef unsigned short bf16_t;
typedef short bf16x8 __attribute__((ext_vector_type(8)));
typedef float f32x4 __attribute__((ext_vector_type(4)));
typedef unsigned u32x4 __attribute__((ext_vector_type(4)));
constexpr int BM = 256, BK = 64, HALF = 128, HTB = HALF * BK * 2  , STAGE_BYTES = 8 * HTB, NXCD = 8, WGM = 8;

__host__ __device__ __forceinline__ int lds_byte(int r, int c) { const int st = (r >> 4) * 2 + (c >> 5), rr = r & 15, cc = c & 31, ob = rr * 64 + cc * 2; return st * 1024 + (ob ^ (((ob >> 9) & 1) << 5)); }
__host__ __device__ __forceinline__ void stage_rc(int b, int& R, int& C) { const int st = b / 1024, sb = b % 1024, swz = sb ^ (((sb >> 9) & 1) << 5); R = (st >> 1) * 16 + swz / 64; C = (st & 1) * 32 + (swz % 64) / 2; }
__host__ __device__ __forceinline__ int perm32(int rho) { const int n = rho >> 4, i = rho & 15; return 8 * (i >> 2) + 4 * n + (i & 3); }

struct Unit { int pm, pn; };
struct Gemm { const bf16_t* A; const bf16_t* Bt; int M, N, K; };

struct StaticOrder {
    int nM, nN, nwg, G, c;
    __host__ __device__ void init(int M, int N, int G_, int c_) { nM = M / BM; nN = N / BM; nwg = nM * nN; G = G_; c = c_; }
    __host__ __device__ bool next(int i, Unit& u) const {
        const long L = (long)i * G + c; if (L >= nwg) return false;
        int wgid = (int)L; { const int q = nwg / NXCD, r = nwg % NXCD, xcd = wgid % NXCD, off = wgid / NXCD; wgid = (xcd < r ? xcd * (q + 1) : r * (q + 1) + (xcd - r) * q) + off; }
        const int nig = WGM * nN, gid = wgid / nig, fm = gid * WGM, gsz = (nM - fm) < WGM ? (nM - fm) : WGM;
        u.pm = fm + ((wgid % nig) % gsz); u.pn = (wgid % nig) / gsz; return true;
    }
    __device__ __forceinline__ void a_ready(const Unit&) const {}
    __device__ __forceinline__ void done(const Unit&) const {}
};

__device__ __forceinline__ unsigned cvt_pk_bf16(float lo, float hi) { unsigned r; asm volatile("v_cvt_pk_bf16_f32 %0, %1, %2" : "=v"(r) : "v"(lo), "v"(hi)); return r; }
typedef float f32x2 __attribute__((ext_vector_type(2)));
__device__ __forceinline__ f32x2 gelu_pk(f32x2 v) {
    const f32x2 av = __builtin_elementwise_abs(v), d = av * 0.2316418882f + 1.0f;
    f32x2 t; t.x = __builtin_amdgcn_rcpf(d.x); t.y = __builtin_amdgcn_rcpf(d.y);
    f32x2 q = t * 0.5307027145f + (-0.7265760135f); q = q * t + 0.7107068705f; q = q * t + (-0.142248368f); q = q * t + 0.127414796f; q = q * t;
    const f32x2 s = (v * v) * (-0.72134752044f);
    f32x2 e; e.x = __builtin_amdgcn_exp2f(s.x); e.y = __builtin_amdgcn_exp2f(s.y);
    const f32x2 m = v * (q * e), r = v - m;
    f32x2 o; o.x = v.x < 0.f ? m.x : r.x; o.y = v.y < 0.f ? m.y : r.y; return o;
}

template <int ACT  > struct EpiBf16 {
    static constexpr bool PERM = true, AFTER_DRAIN = false; static_assert(ACT == 0 || ACT == 1, "EpiBf16: ACT is 0 (none) or 1 (gelu_pk)");
    bf16_t* O; int ldc; const float* bias; int split_cols; size_t split_stride; float scale0;
    __device__ __forceinline__ void operator()(const f32x4 (&acc)[2][2][4][2], const Unit& u, int wr, int wc, int fr, int fq) const {
        const int row0 = u.pm * BM + wr * 64 + fr; int colt = u.pn * BM; bf16_t* base = O;
        float sc = 1.f; if (split_cols) { const int t = colt / split_cols; base += (size_t)t * split_stride; colt -= t * split_cols; if (t == 0) sc = scale0; }
        const int col0 = colt + wc * 32 + 8 * fq, bcol0 = u.pn * BM + wc * 32 + 8 * fq;
        f32x4 bv[2][2];
#pragma unroll
        for (int bj = 0; bj < 2; ++bj)
#pragma unroll
            for (int n = 0; n < 2; ++n) bv[bj][n] = bias ? *(const f32x4*)(bias + bcol0 + bj * HALF + 4 * n) : (f32x4){0.f, 0.f, 0.f, 0.f};
#pragma unroll
        for (int ai = 0; ai < 2; ++ai)
#pragma unroll
            for (int m = 0; m < 4; ++m) { bf16_t* rowp = base + (size_t)(row0 + ai * HALF + m * 16) * ldc + col0;
#pragma unroll
                for (int bj = 0; bj < 2; ++bj) { f32x4 v0 = acc[ai][bj][m][0] + bv[bj][0], v1 = acc[ai][bj][m][1] + bv[bj][1];
                    if (ACT == 1) { f32x2 a = gelu_pk((f32x2){v0[0], v0[1]}), b = gelu_pk((f32x2){v0[2], v0[3]}), c = gelu_pk((f32x2){v1[0], v1[1]}), d = gelu_pk((f32x2){v1[2], v1[3]});
                        v0 = (f32x4){a.x, a.y, b.x, b.y}; v1 = (f32x4){c.x, c.y, d.x, d.y}; }
                    v0 = v0 * sc; v1 = v1 * sc; u32x4 w; w.x = cvt_pk_bf16(v0[0], v0[1]); w.y = cvt_pk_bf16(v0[2], v0[3]); w.z = cvt_pk_bf16(v1[0], v1[1]); w.w = cvt_pk_bf16(v1[2], v1[3]);
                    *(u32x4*)(rowp + bj * HALF) = w; } }
    }
};


template <class Epi, class Sched, bool ALIGN_EPI = false, bool SP2 = false>
__device__ __forceinline__ void gemm_phase(PG8_LAS unsigned char* lds, const Gemm g, const Sched& S, const Epi& E, const int wid) {
    int lane_; asm volatile("v_mbcnt_lo_u32_b32 %0, -1, 0\n\tv_mbcnt_hi_u32_b32 %0, -1, %0" : "=v"(lane_)); const int lane = lane_, tid = wid * 64 + lane, wr = wid >> 2, wc = wid & 3, fr = lane & 15, fq = lane >> 4;
    const int K = g.K, nt = K / BK;
    unsigned voffA[2], voffB[2];
#pragma unroll
    for (int i = 0; i < 2; ++i) { int R, C; stage_rc(tid * 16 + i * 8192, R, C); const int Rb = Epi::PERM ? ((R & ~31) + perm32(R & 31)) : R;
        voffA[i] = (unsigned)(R * K + C) * 2u; voffB[i] = (unsigned)(Rb * K + C) * 2u; }
    const size_t kstep = (size_t)(BK * 2);
    const size_t hstep = (size_t)HALF * K * 2;
    const size_t tstep = 2 * hstep;
    const unsigned ldsw = (unsigned)wid * 1024u;
    const int aoff = lds_byte(wr * 64 + fr, fq * 8), boff = lds_byte(wc * 32 + fr, fq * 8);
#define PG8_SA(b, h) (((b) * 2 + (h)) * HTB)
#define PG8_SB(b, h) ((4 + (b) * 2 + (h)) * HTB)
#define PG8_STAGE(bufoff, gbase, voff) do { _Pragma("unroll") for (int _i = 0; _i < 2; ++_i) \
        __builtin_amdgcn_global_load_lds((const unsigned*)((const char*)(gbase) + (voff)[_i]), (PG8_LAS unsigned*)(lds + (bufoff) + ldsw + _i * 8192), 16, 0, 0); } while (0)
#define PG8_LDA(dst, b, h) do { _Pragma("unroll") for (int m = 0; m < 4; ++m) _Pragma("unroll") for (int k = 0; k < 2; ++k) dst[m][k] = *(const PG8_LAS bf16x8*)(lds + PG8_SA(b, h) + aoff + m * 2048 + k * 1024); } while (0)
#define PG8_LDB(dst, b, h) do { _Pragma("unroll") for (int n = 0; n < 2; ++n) _Pragma("unroll") for (int k = 0; k < 2; ++k) dst[n][k] = *(const PG8_LAS bf16x8*)(lds + PG8_SB(b, h) + boff + n * 2048 + k * 1024); } while (0)
#define PG8_MMA(ai, bj, At, Bt) do { __builtin_amdgcn_s_setprio(1); _Pragma("unroll") for (int m = 0; m < 4; ++m) _Pragma("unroll") for (int n = 0; n < 2; ++n) _Pragma("unroll") for (int k = 0; k < 2; ++k) \
        acc[ai][bj][m][n] = __builtin_amdgcn_mfma_f32_16x16x32_bf16(Bt[n][k], At[m][k], acc[ai][bj][m][n], 0, 0, 0); __builtin_amdgcn_s_setprio(0); } while (0)
#define PG8_WAIT_V(n) asm volatile("s_waitcnt vmcnt(" #n ")" ::: "memory")
#define PG8_WAIT_L(n) asm volatile("s_waitcnt lgkmcnt(" #n ")" ::: "memory")
#define PG8_BAR __builtin_amdgcn_s_barrier()
#define PG8_SCHED __builtin_amdgcn_sched_barrier(0)
    Unit cur, nxt; int ui = 0;
    if (!S.next(0, cur)) return;
    f32x4 acc[2][2][4][2];
#pragma unroll
    for (int a = 0; a < 2; ++a)
#pragma unroll
        for (int b = 0; b < 2; ++b)
#pragma unroll
            for (int m = 0; m < 4; ++m)
#pragma unroll
                for (int n = 0; n < 2; ++n) acc[a][b][m][n] = (f32x4){0.f, 0.f, 0.f, 0.f};
    bf16x8 At[4][2], B0[2][2], B1[2][2];
    const char* cA = (const char*)g.A + (size_t)cur.pm * tstep; const char* cB = (const char*)g.Bt + (size_t)cur.pn * tstep;
    S.a_ready(cur);
    if constexpr (SP2) {
        PG8_STAGE(PG8_SB(0, 0), cB, voffB); PG8_STAGE(PG8_SB(0, 1), cB + hstep, voffB); PG8_STAGE(PG8_SA(0, 0), cA, voffA); PG8_STAGE(PG8_SA(0, 1), cA + hstep, voffA);
        if (wr == 1) PG8_BAR;
        PG8_WAIT_V(2); PG8_BAR;
        PG8_STAGE(PG8_SB(1, 0), cB + kstep, voffB); PG8_STAGE(PG8_SA(1, 0), cA + kstep, voffA); PG8_STAGE(PG8_SB(1, 1), cB + hstep + kstep, voffB);
        PG8_WAIT_V(6); PG8_BAR;
    } else {
        PG8_STAGE(PG8_SB(0, 0), cB, voffB); PG8_STAGE(PG8_SA(0, 0), cA, voffA); PG8_STAGE(PG8_SB(0, 1), cB + hstep, voffB); PG8_STAGE(PG8_SA(0, 1), cA + hstep, voffA);
        if (wr == 1) PG8_BAR;
        PG8_WAIT_V(4); PG8_BAR;
        PG8_STAGE(PG8_SB(1, 0), cB + kstep, voffB); PG8_STAGE(PG8_SA(1, 0), cA + kstep, voffA); PG8_STAGE(PG8_SB(1, 1), cB + hstep + kstep, voffB);
        PG8_WAIT_V(6); PG8_BAR;
    }
    for (;;) {
        const bool has_next = S.next(ui + 1, nxt);
        const char* nA = has_next ? (const char*)g.A + (size_t)nxt.pm * tstep : cA; const char* nB = has_next ? (const char*)g.Bt + (size_t)nxt.pn * tstep : cB;
        for (int t = 0; t < nt; t += 2) {
            const bool last = (t == nt - 2);
            const char* a1 = cA + (size_t)(t + 1) * kstep;
            const char* a2 = last ? nA : cA + (size_t)(t + 2) * kstep; const char* b2 = last ? nB : cB + (size_t)(t + 2) * kstep;
            const char* a3 = a2 + kstep; const char* b3 = b2 + kstep;
            if (last && has_next) S.a_ready(nxt);
            if constexpr (SP2) {
            PG8_LDB(B0, 0, 0); PG8_LDB(B1, 0, 1); PG8_SCHED; PG8_LDA(At, 0, 0); PG8_STAGE(PG8_SA(1, 1), a1 + hstep, voffA);
            PG8_WAIT_V(8); PG8_WAIT_L(0); PG8_BAR; PG8_MMA(0, 0, At, B0); PG8_MMA(0, 1, At, B1); PG8_BAR; PG8_SCHED;
            PG8_LDA(At, 0, 1); PG8_STAGE(PG8_SB(0, 0), b2, voffB); PG8_STAGE(PG8_SB(0, 1), b2 + hstep, voffB); PG8_STAGE(PG8_SA(0, 0), a2, voffA);
            PG8_WAIT_V(8); PG8_WAIT_L(0); PG8_BAR; PG8_MMA(1, 0, At, B0); PG8_MMA(1, 1, At, B1); PG8_BAR; PG8_SCHED;
            PG8_LDB(B0, 1, 0); PG8_LDB(B1, 1, 1); PG8_SCHED; PG8_LDA(At, 1, 0); PG8_STAGE(PG8_SA(0, 1), a2 + hstep, voffA);
            PG8_WAIT_V(8); PG8_WAIT_L(0); PG8_BAR; PG8_MMA(0, 0, At, B0); PG8_MMA(0, 1, At, B1); PG8_BAR; PG8_SCHED;
            PG8_LDA(At, 1, 1); PG8_STAGE(PG8_SB(1, 0), b3, voffB); PG8_STAGE(PG8_SB(1, 1), b3 + hstep, voffB); PG8_STAGE(PG8_SA(1, 0), a3, voffA);
            PG8_WAIT_V(8); PG8_WAIT_L(0); PG8_BAR; PG8_MMA(1, 0, At, B0); PG8_MMA(1, 1, At, B1); PG8_BAR; PG8_SCHED;
            } else {
            PG8_LDB(B0, 0, 0); PG8_SCHED; PG8_LDA(At, 0, 0); PG8_STAGE(PG8_SA(1, 1), a1 + hstep, voffA);
            PG8_WAIT_L(8); PG8_BAR; PG8_WAIT_L(0); PG8_MMA(0, 0, At, B0); PG8_BAR; PG8_SCHED;
            PG8_LDB(B1, 0, 1); PG8_STAGE(PG8_SB(0, 0), b2, voffB);
            PG8_BAR; PG8_WAIT_L(0); PG8_MMA(0, 1, At, B1); PG8_BAR;
            PG8_LDA(At, 0, 1); PG8_STAGE(PG8_SA(0, 0), a2, voffA);
            PG8_BAR; PG8_WAIT_L(0); PG8_MMA(1, 0, At, B0); PG8_BAR; PG8_SCHED;
            PG8_STAGE(PG8_SB(0, 1), b2 + hstep, voffB);
            PG8_WAIT_V(6); PG8_BAR; PG8_MMA(1, 1, At, B1); PG8_BAR;
            PG8_LDB(B0, 1, 0); PG8_SCHED; PG8_LDA(At, 1, 0); PG8_STAGE(PG8_SA(0, 1), a2 + hstep, voffA);
            PG8_WAIT_L(8); PG8_BAR; PG8_WAIT_L(0); PG8_MMA(0, 0, At, B0); PG8_BAR; PG8_SCHED;
            PG8_LDB(B1, 1, 1); PG8_STAGE(PG8_SB(1, 0), b3, voffB);
            PG8_BAR; PG8_WAIT_L(0); PG8_MMA(0, 1, At, B1); PG8_BAR;
            PG8_LDA(At, 1, 1); PG8_STAGE(PG8_SA(1, 0), a3, voffA);
            PG8_BAR; PG8_WAIT_L(0); PG8_MMA(1, 0, At, B0); PG8_BAR; PG8_SCHED;
            PG8_STAGE(PG8_SB(1, 1), b3 + hstep, voffB);
            PG8_WAIT_V(6); PG8_BAR; PG8_MMA(1, 1, At, B1); PG8_BAR;
            }
        }
        if constexpr (ALIGN_EPI) { if (wr == 0) PG8_BAR; }
        if constexpr (!Epi::AFTER_DRAIN) { E(acc, cur, wr, wc, fr, fq); S.done(cur); }
        if (!has_next) break;
#pragma unroll
        for (int a = 0; a < 2; ++a)
#pragma unroll
            for (int b = 0; b < 2; ++b)
#pragma unroll
                for (int m = 0; m < 4; ++m)
#pragma unroll
                    for (int n = 0; n < 2; ++n) acc[a][b][m][n] = (f32x4){0.f, 0.f, 0.f, 0.f};
        cur = nxt; cA = nA; cB = nB; ++ui;
        if constexpr (ALIGN_EPI) { if (wr == 1) PG8_BAR; }
    }
    PG8_WAIT_V(0);
    if constexpr (!ALIGN_EPI) { if (wr == 0) PG8_BAR; }
    PG8_BAR;
    if constexpr (Epi::AFTER_DRAIN) { E.fused(acc, cur, wr, wc, fr, fq, lds, wid, lane); S.done(cur); }
#undef PG8_SA
#undef PG8_SB
#undef PG8_STAGE
#undef PG8_LDA
#undef PG8_LDB
#undef PG8_MMA
#undef PG8_WAIT_V
#undef PG8_WAIT_L
#undef PG8_BAR
#undef PG8_SCHED
}
}

constexpr int DM = 1024, NB = 16, SEQ = 2048, MPR = NB * SEQ  , NS = 128  , MV = MPR + NS  , MPAD = 33024  ;
constexpr int ATT_IN = 4608, RET_IN = 6144, AW = 2048  , KVW = 256;
constexpr int PAST = 16384;
constexpr float EPS = 1e-6f;
constexpr float LOG2E = 1.4426950408889634f;
constexpr float C2 = 0.125f * LOG2E;
constexpr int NWAVES = 8, NTHR = 512;

constexpr size_t O_YP = 0, O_YS = 33554432, O_KP = 33685504, O_VP = 34209792, O_RP = 34734080, O_KS = 43122688, O_VS = 47316992, O_RS = 51511296, O_END = 118620160;

constexpr size_t MiB = 1u << 20;
constexpr size_t WS_WINA = 1 * MiB;
constexpr size_t WS_WOA  = 11 * MiB;
constexpr size_t WS_WINR = 16 * MiB;
constexpr size_t WS_WOR  = 29 * MiB;
constexpr size_t WS_COS  = 34 * MiB;
constexpr size_t WS_SIN  = 36 * MiB;
constexpr size_t WS_BT   = 38 * MiB;
constexpr size_t WS_SSQ1 = 39 * MiB;
constexpr size_t WS_STAT = 42 * MiB;
constexpr size_t WS_XN   = 60 * MiB;
constexpr size_t WS_Q    = 126 * MiB;
constexpr size_t WS_K    = 256 * MiB;
constexpr size_t WS_V    = 273 * MiB;
constexpr size_t WS_SG   = 290 * MiB;
constexpr size_t WS_OG   = 420 * MiB;
constexpr size_t WS_X1   = 550 * MiB;
constexpr size_t WS_ORAW = 680 * MiB;
constexpr size_t WS_END  = 810 * MiB;
static_assert(WS_WINA + (size_t)ATT_IN * DM * 2 <= WS_WOA && WS_WOA + (size_t)DM * AW * 2 <= WS_WINR && WS_WINR + (size_t)RET_IN * DM * 2 <= WS_WOR && WS_WOR + (size_t)DM * AW * 2 <= WS_COS, "ws map weights");
static_assert(WS_COS + 2049 * 128 * 4 <= WS_SIN && WS_SIN + 2049 * 128 * 4 <= WS_BT && WS_SSQ1 + (size_t)MPAD * 16 * 4 <= WS_STAT && WS_STAT + (size_t)MPAD * 4 * 16 * 2 * 4 <= WS_XN, "ws map tables");
static_assert(WS_XN + (size_t)MPAD * DM * 2 <= WS_Q && WS_Q + (size_t)MPAD * AW * 2 <= WS_K && WS_K + (size_t)MPAD * KVW * 2 <= WS_V && WS_V + (size_t)MPAD * KVW * 2 <= WS_SG, "ws map act 1");
static_assert(WS_SG + (size_t)MPAD * AW * 2 <= WS_OG && WS_OG + (size_t)MPAD * AW * 2 <= WS_X1 && WS_X1 + (size_t)MPAD * DM * 4 <= WS_ORAW && WS_ORAW + (size_t)MPAD * AW * 2 <= WS_END, "ws map act 2");

constexpr int LDS_BYTES = 147456;

#define GAS __attribute__((address_space(1)))
#define LAS __attribute__((address_space(3)))
typedef unsigned short bf16;
typedef unsigned v4u __attribute__((ext_vector_type(4)));
typedef unsigned v2u __attribute__((ext_vector_type(2)));
typedef float f32x4 __attribute__((ext_vector_type(4)));
typedef float f32x16 __attribute__((ext_vector_type(16)));
typedef short bf16x8 __attribute__((ext_vector_type(8)));
typedef short s16x4 __attribute__((ext_vector_type(4)));
#define LDS_WAIT() asm volatile("s_waitcnt lgkmcnt(0)" ::: "memory")
#define VM_WAIT() asm volatile("s_waitcnt vmcnt(0)" ::: "memory")

__device__ __forceinline__ unsigned f2bf(float f) { unsigned u = __builtin_bit_cast(unsigned, f); return (u + 0x7fffu + ((u >> 16) & 1u)) >> 16; }
typedef float f32x2_t __attribute__((ext_vector_type(2))); typedef __bf16 bf16x2_t __attribute__((ext_vector_type(2)));
__device__ __forceinline__ unsigned cvtpk(float lo, float hi) { f32x2_t v = {lo, hi}; bf16x2_t b = __builtin_convertvector(v, bf16x2_t); return __builtin_bit_cast(unsigned, b); }
__device__ __forceinline__ unsigned pk2(float lo, float hi) { return cvtpk(lo, hi); }
__device__ __forceinline__ float bf2f(unsigned short b) { return __builtin_bit_cast(float, (unsigned)b << 16); }
__device__ __forceinline__ float bflo(unsigned w) { return __builtin_bit_cast(float, w << 16); }
__device__ __forceinline__ float bfhi(unsigned w) { return __builtin_bit_cast(float, w & 0xffff0000u); }
__device__ __forceinline__ float silu_f(float x) { return x * __builtin_amdgcn_rcpf(1.0f + __expf(-x)); }
__device__ __forceinline__ float wave_sum(float v) {
#pragma unroll
    for (int o = 1; o < 64; o <<= 1) v += __shfl_xor(v, o);
    return v;
}
__device__ __forceinline__ float wave_max(float v) {
#pragma unroll
    for (int o = 1; o < 64; o <<= 1) v = fmaxf(v, __shfl_xor(v, o));
    return v;
}

struct Args { const float* in[13]; float* out; unsigned char* ws; int ph_lo, ph_hi; };

struct Frame {
    LAS unsigned char* lds;
    int wave, vcu, G;
    const float *xp, *xs, *ck, *cv, *st, *ng, *fg, *rb, *wia, *sk, *woa, *wir, *wor;
    float* out; unsigned char* ws;
};

__device__ __forceinline__ int lane_id() { int l; asm volatile("v_mbcnt_lo_u32_b32 %0, -1, 0\n\tv_mbcnt_hi_u32_b32 %0, -1, %0" : "=v"(l)); return l; }
__device__ __forceinline__ int cur_tid(const Frame& F) { return F.wave * 64 + lane_id(); }
__device__ __forceinline__ void p0_transpose_item(const float* W, int K, int N, bf16* WT, LAS float* scr, int item, int lane, const float* gk = nullptr) {
    const int nblk = N / 32, kb = item / nblk, nb = item % nblk, k0 = 64 * kb, n0 = 32 * nb;
#pragma unroll 8
    for (int i = 0; i < 32; ++i) { const int kk = 2 * i + (lane >> 5); const float gv = gk ? gk[k0 + kk] : 1.0f; scr[kk * 33 + (lane & 31)] = W[(size_t)(k0 + kk) * N + n0 + (lane & 31)] * gv; }
    LDS_WAIT(); asm volatile("" ::: "memory");
    const int c = lane & 7;
#pragma unroll
    for (int j = 0; j < 4; ++j) { const int n = (lane >> 3) + 8 * j; const LAS float* s = scr + (8 * c) * 33 + n;
        v4u o; o.x = pk2(s[0 * 33], s[1 * 33]); o.y = pk2(s[2 * 33], s[3 * 33]); o.z = pk2(s[4 * 33], s[5 * 33]); o.w = pk2(s[6 * 33], s[7 * 33]);
        *(GAS v4u*)(WT + (size_t)(n0 + n) * K + k0 + 8 * c) = o; }
    LDS_WAIT(); asm volatile("" ::: "memory");
}
__device__ __forceinline__ void rms_row_to_bf16(int lane, const float* xrow, const float* g, bf16* orow) {
    const GAS f32x4* xr = (const GAS f32x4*)xrow + lane; const GAS f32x4* gr = (const GAS f32x4*)g + lane;
    f32x4 v[4]; float s = 0.f;
#pragma unroll
    for (int j = 0; j < 4; ++j) { v[j] = xr[64 * j]; s += (v[j].x * v[j].x + v[j].y * v[j].y) + (v[j].z * v[j].z + v[j].w * v[j].w); }
    const float rstd = 1.0f / sqrtf(wave_sum(s) * (1.f / DM) + EPS);
    GAS unsigned long long* o8 = (GAS unsigned long long*)orow + lane;
#pragma unroll
    for (int j = 0; j < 4; ++j) { const f32x4 gg = gr[64 * j];
        o8[64 * j] = (unsigned long long)pk2(v[j].x * rstd * gg.x, v[j].y * rstd * gg.y) | ((unsigned long long)pk2(v[j].z * rstd * gg.z, v[j].w * rstd * gg.w) << 32); }
}
__device__ __forceinline__ int t5_bucket(int n) {
    if (n < 16) return n;
    int l = 16 + (int)(logf((float)n / 16.0f) / logf(8.0f) * 16.0f);
    return l < 31 ? l : 31;
}
__device__ __forceinline__ void p0_prologue(Frame& F) {
    LAS float* scr = (LAS float*)(F.lds + F.wave * 16384);
    const int gw = F.vcu * NWAVES + F.wave, NGW = F.G * NWAVES;
    bf16* WinA = (bf16*)(F.ws + WS_WINA); bf16* WoA = (bf16*)(F.ws + WS_WOA); bf16* WinR = (bf16*)(F.ws + WS_WINR); bf16* WoR = (bf16*)(F.ws + WS_WOR);
    constexpr int I_A = (DM / 64) * (ATT_IN / 32), I_B = (AW / 64) * (DM / 32), I_C = (DM / 64) * (RET_IN / 32), I_D = I_B;
    constexpr int NITEMS = I_A + I_B + I_C + I_D;
    for (int it = gw; it < NITEMS; it += NGW) {
        int r = it;
        if (r < I_A) { p0_transpose_item(F.wia, DM, ATT_IN, WinA, scr, r, lane_id()); continue; } r -= I_A;
        if (r < I_B) { p0_transpose_item(F.woa, AW, DM, WoA, scr, r, lane_id()); continue; } r -= I_B;
        if (r < I_C) { p0_transpose_item(F.wir, DM, RET_IN, WinR, scr, r, lane_id(), F.ng + DM); continue; } r -= I_C;
        p0_transpose_item(F.wor, AW, DM, WoR, scr, r, lane_id());
    }
    bf16* XN = (bf16*)(F.ws + WS_XN);
    for (int m = gw; m < MPAD; m += NGW) {
        if (m < MPR) rms_row_to_bf16(lane_id(), F.xp + (size_t)m * DM, F.ng, XN + (size_t)m * DM);
        else if (m < MV) rms_row_to_bf16(lane_id(), F.xs + (size_t)(m - MPR) * DM, F.ng, XN + (size_t)m * DM);
        else { GAS unsigned long long* o8 = (GAS unsigned long long*)(XN + (size_t)m * DM) + lane_id();
#pragma unroll
            for (int j = 0; j < 4; ++j) o8[64 * j] = 0ull; }
    }
    const int gt = F.vcu * NTHR + cur_tid(F), NGT = F.G * NTHR;
    float* COS = (float*)(F.ws + WS_COS); float* SIN = (float*)(F.ws + WS_SIN); float* BT = (float*)(F.ws + WS_BT);
    for (int i = gt; i < 2049 * 128; i += NGT) {
        const int p = i >> 7, f = i & 127; const double pos = (p == 2048) ? (double)PAST : (double)p;
        const double inv = exp(-(double)f * (9.210340371976184 / 128.0));
        const double ang = pos * inv;
        COS[i] = (float)cos(ang); SIN[i] = (float)sin(ang);
    }
    for (int i = gt; i < 32 * 128; i += NGT) { const int h = i >> 7, rel = i & 127; BT[i] = F.rb[t5_bucket(rel) * 32 + h] * LOG2E; }
    {   const GAS f32x4* ck = (const GAS f32x4*)F.ck; const GAS f32x4* cv = (const GAS f32x4*)F.cv;
        GAS f32x4* ok = (GAS f32x4*)(F.out + O_KS); GAS f32x4* ov = (GAS f32x4*)(F.out + O_VS);
        for (int i = gt; i < NS * 127 * 64; i += NGT) { const int s = i / (127 * 64), r = i - s * (127 * 64);
            ok[(size_t)s * 8192 + r] = ck[(size_t)s * 8192 + 64 + r]; ov[(size_t)s * 8192 + r] = cv[(size_t)s * 8192 + 64 + r]; } }
}

struct EpiAttnIn {
    static constexpr bool PERM = true, AFTER_DRAIN = false;
    bf16 *Q, *K, *V, *SG; float* out;
    __device__ __forceinline__ void operator()(const pg8::f32x4 (&acc)[2][2][4][2], const pg8::Unit& u, int wr, int wc, int fr, int fq) const {
        const int pn = u.pn, row0 = u.pm * 256 + wr * 64 + fr, cl0 = wc * 32 + 8 * fq;
#pragma unroll
        for (int ai = 0; ai < 2; ++ai)
#pragma unroll
            for (int m = 0; m < 4; ++m) { const int row = row0 + ai * 128 + m * 16;
#pragma unroll
                for (int bj = 0; bj < 2; ++bj) { const int cl = cl0 + bj * 128; pg8::f32x4 v0 = acc[ai][bj][m][0], v1 = acc[ai][bj][m][1];
                    if (pn < 8) { v0 = v0 * C2; v1 = v1 * C2; v4u w; w.x = pk2(v0[0], v0[1]); w.y = pk2(v0[2], v0[3]); w.z = pk2(v1[0], v1[1]); w.w = pk2(v1[2], v1[3]);
                        *(GAS v4u*)(Q + (size_t)row * AW + pn * 256 + cl) = w; }
                    else if (pn < 10) { v4u w; w.x = pk2(v0[0], v0[1]); w.y = pk2(v0[2], v0[3]); w.z = pk2(v1[0], v1[1]); w.w = pk2(v1[2], v1[3]);
                        bf16* dst = (pn == 8) ? K : V; *(GAS v4u*)(dst + (size_t)row * KVW + cl) = w;
                        float* o = nullptr;
                        if (row < MPR) { const int b = row >> 11, t = row & 2047; if (t >= SEQ - 128) o = out + (pn == 8 ? O_KP : O_VP) + (size_t)(b * 128 + t - (SEQ - 128)) * 256 + cl; }
                        else if (row < MV) { o = out + (pn == 8 ? O_KS : O_VS) + (size_t)((row - MPR) * 128 + 127) * 256 + cl; }
                        if (o) { *(GAS f32x4*)o = v0; *(GAS f32x4*)(o + 4) = v1; } }
                    else { v4u w; w.x = pk2(silu_f(v0[0]), silu_f(v0[1])); w.y = pk2(silu_f(v0[2]), silu_f(v0[3])); w.z = pk2(silu_f(v1[0]), silu_f(v1[1])); w.w = pk2(silu_f(v1[2]), silu_f(v1[3]));
                        *(GAS v4u*)(SG + (size_t)row * AW + (pn - 10) * 256 + cl) = w; } } }
    }
};

struct EpiOutRes {
    static constexpr bool PERM = false, AFTER_DRAIN = false;
    const float *xp, *xs; bf16* XN2; float* ssq;
    __device__ __forceinline__ void operator()(const pg8::f32x4 (&acc)[2][2][4][2], const pg8::Unit& u, int wr, int wc, int fr, int fq) const {
        const int row0 = u.pm * 256 + wr * 64 + fr, c0 = u.pn * 256 + wc * 32 + 4 * fq;
#pragma unroll
        for (int ai = 0; ai < 2; ++ai)
#pragma unroll
            for (int m = 0; m < 4; ++m) { const int row = row0 + ai * 128 + m * 16; const bool ok = row < MV;
                const float* xr = (row < MPR) ? xp + (size_t)row * DM : xs + (size_t)(ok ? row - MPR : 0) * DM;
                float sq = 0.f;
#pragma unroll
                for (int bj = 0; bj < 2; ++bj)
#pragma unroll
                    for (int n = 0; n < 2; ++n) { const int col = c0 + bj * 128 + n * 16;
                        if (ok) { const f32x4 x = *(const GAS f32x4*)(xr + col); const f32x4 v = x + acc[ai][bj][m][n];
                            v2u w; w.x = pk2(v[0], v[1]); w.y = pk2(v[2], v[3]); *(GAS v2u*)(XN2 + (size_t)row * DM + col) = w;
                            sq += (v[0] * v[0] + v[1] * v[1]) + (v[2] * v[2] + v[3] * v[3]); } }
                sq += __shfl_xor(sq, 16); sq += __shfl_xor(sq, 32);
                if (ok && fq == 0) ssq[(size_t)row * 16 + u.pn * 4 + wc] = sq; }
    }
};
struct EpiOutFinal {
    static constexpr bool PERM = false, AFTER_DRAIN = false;
    const bf16* X1b; float* out;
    __device__ __forceinline__ void operator()(const pg8::f32x4 (&acc)[2][2][4][2], const pg8::Unit& u, int wr, int wc, int fr, int fq) const {
        const int row0 = u.pm * 256 + wr * 64 + fr, c0 = u.pn * 256 + wc * 32 + 4 * fq;
#pragma unroll
        for (int ai = 0; ai < 2; ++ai)
#pragma unroll
            for (int m = 0; m < 4; ++m) { const int row = row0 + ai * 128 + m * 16;
                if (row < MV) { float* orow = (row < MPR) ? out + O_YP + (size_t)row * DM : out + O_YS + (size_t)(row - MPR) * DM;
#pragma unroll
                    for (int bj = 0; bj < 2; ++bj)
#pragma unroll
                        for (int n = 0; n < 2; ++n) { const int col = c0 + bj * 128 + n * 16;
                            const v2u xw = *(const GAS v2u*)(X1b + (size_t)row * DM + col); const f32x4 x = {bflo(xw.x), bfhi(xw.x), bflo(xw.y), bfhi(xw.y)}; *(GAS f32x4*)(orow + col) = x + acc[ai][bj][m][n]; } } }
    }
};
struct EpiRetIn {
    static constexpr bool PERM = true, AFTER_DRAIN = false;
    const float *ssq, *COS, *SIN; bf16 *Qr, *Kr, *Vr, *SG2;
    __device__ __forceinline__ void operator()(const pg8::f32x4 (&acc)[2][2][4][2], const pg8::Unit& u, int wr, int wc, int fr, int fq) const {
        const int pn = u.pn, row0 = u.pm * 256 + wr * 64 + fr, cl0 = wc * 32 + 8 * fq;
#pragma unroll
        for (int ai = 0; ai < 2; ++ai)
#pragma unroll
            for (int m = 0; m < 4; ++m) { const int row = row0 + ai * 128 + m * 16;
                float rstd = 0.f;
                if (row < MV) { const GAS f32x4* sp = (const GAS f32x4*)(ssq + (size_t)row * 16); const f32x4 a = sp[0], b = sp[1], c = sp[2], d = sp[3];
                    const float s = ((a[0] + a[1]) + (a[2] + a[3])) + ((b[0] + b[1]) + (b[2] + b[3])) + ((c[0] + c[1]) + (c[2] + c[3])) + ((d[0] + d[1]) + (d[2] + d[3]));
                    rstd = 1.0f / sqrtf(s * (1.f / DM) + EPS); }
                if (pn < 8) {
                    const int p = (row < MPR) ? (row & 2047) : 2048;
                    const float lg = __builtin_amdgcn_logf(1.0f - __builtin_amdgcn_exp2f(-5.0f - (float)(pn & 3))) * (float)(row & 63);
                    const float sc = (pn < 4) ? rstd * __builtin_amdgcn_exp2f(lg) : rstd * 0.0625f * __builtin_amdgcn_exp2f(-lg);
                    bf16* dst = ((pn < 4) ? Qr : Kr) + (size_t)row * DM + (pn & 3) * 256 + cl0;
                    const GAS f32x4* cp = (const GAS f32x4*)(COS + p * 128 + cl0); const GAS f32x4* sp = (const GAS f32x4*)(SIN + p * 128 + cl0);
                    v4u w1, w2;
#pragma unroll
                    for (int n = 0; n < 2; ++n) { const f32x4 cc = cp[n], ss = sp[n]; const f32x4 x1 = acc[ai][0][m][n] * sc, x2 = acc[ai][1][m][n] * sc;
                        const f32x4 o1 = x1 * cc - x2 * ss, o2 = x1 * ss + x2 * cc;
                        if (n == 0) { w1.x = pk2(o1[0], o1[1]); w1.y = pk2(o1[2], o1[3]); w2.x = pk2(o2[0], o2[1]); w2.y = pk2(o2[2], o2[3]); }
                        else { w1.z = pk2(o1[0], o1[1]); w1.w = pk2(o1[2], o1[3]); w2.z = pk2(o2[0], o2[1]); w2.w = pk2(o2[2], o2[3]); } }
                    *(GAS v4u*)dst = w1; *(GAS v4u*)(dst + 128) = w2;
                } else {
#pragma unroll
                    for (int bj = 0; bj < 2; ++bj) { const int cl = cl0 + bj * 128; const pg8::f32x4 v0 = acc[ai][bj][m][0] * rstd, v1 = acc[ai][bj][m][1] * rstd; v4u w;
                        if (pn < 16) { w.x = pk2(v0[0], v0[1]); w.y = pk2(v0[2], v0[3]); w.z = pk2(v1[0], v1[1]); w.w = pk2(v1[2], v1[3]);
                            *(GAS v4u*)(Vr + (size_t)row * AW + (pn - 8) * 256 + cl) = w; }
                        else { w.x = pk2(silu_f(v0[0]), silu_f(v0[1])); w.y = pk2(silu_f(v0[2]), silu_f(v0[3])); w.z = pk2(silu_f(v1[0]), silu_f(v1[1])); w.w = pk2(silu_f(v1[2]), silu_f(v1[3]));
                            *(GAS v4u*)(SG2 + (size_t)row * AW + (pn - 16) * 256 + cl) = w; } }
                } }
    }
};

#define MFMA32(a, b, c) __builtin_amdgcn_mfma_f32_32x32x16_bf16((a), (b), (c), 0, 0, 0)
#define MFMA16(a, b, c) __builtin_amdgcn_mfma_f32_16x16x32_bf16((a), (b), (c), 0, 0, 0)
typedef short v4i16_t __attribute__((ext_vector_type(4)));
__device__ __forceinline__ int crow(int r, int hi) { return (r & 3) + 8 * (r >> 2) + 4 * hi; }
__device__ __forceinline__ s16x4 vtr(const LAS unsigned char* p) { return __builtin_bit_cast(s16x4, __builtin_amdgcn_ds_read_tr16_b64_v4i16((LAS v4i16_t*)p)); }
__device__ __forceinline__ bf16x8 pack8(const f32x16& x, int s) {
    v4u p; p.x = cvtpk(x[8 * s], x[8 * s + 1]); p.y = cvtpk(x[8 * s + 2], x[8 * s + 3]); p.z = cvtpk(x[8 * s + 4], x[8 * s + 5]); p.w = cvtpk(x[8 * s + 6], x[8 * s + 7]);
    return __builtin_bit_cast(bf16x8, p);
}
__device__ __forceinline__ bf16x8 cat44(s16x4 lo, s16x4 hi) { return (bf16x8){lo[0], lo[1], lo[2], lo[3], hi[0], hi[1], hi[2], hi[3]}; }
__device__ __forceinline__ float half_swap_max(float m) { auto rr = __builtin_amdgcn_permlane32_swap(__float_as_uint(m), __float_as_uint(m), false, false); return fmaxf(__uint_as_float(rr[0]), __uint_as_float(rr[1])); }
__device__ __forceinline__ float half_swap_sum(float m) { auto rr = __builtin_amdgcn_permlane32_swap(__float_as_uint(m), __float_as_uint(m), false, false); return __uint_as_float(rr[0]) + __uint_as_float(rr[1]); }

constexpr int AT_KSTR = 2064, AT_VDH = 8256, AT_BLK = 8 * AT_KSTR + 2 * AT_VDH  , AT_VOFF = 8 * AT_KSTR;
constexpr int AT_RING = 0, AT_BT = 3 * AT_BLK  , AT_BTW = 800, AT_WS = AT_BT + 8 * AT_BTW  , AT_OST = AT_WS + 2048  , AT_END = AT_OST + 8 * 4096;
static_assert(AT_END <= LDS_BYTES, "attention LDS");
constexpr float NEGBIG = -1.0e30f;

__device__ __forceinline__ void attn_dma_block(Frame& F, int gid, int lane) {
    const bf16* Kb = (const bf16*)(F.ws + WS_K); const bf16* Vb = (const bf16*)(F.ws + WS_V);
    const int bk = gid >> 4, kvh = bk & 3, b = bk >> 2, qb = gid & 15; const size_t row0 = (size_t)b * SEQ + qb * 128;
    LAS unsigned char* blk = F.lds + AT_RING + (gid % 3) * AT_BLK; const int w = F.wave;
#pragma unroll
    for (int i = 0; i < 2; ++i) {
        __builtin_amdgcn_global_load_lds((const GAS unsigned*)(Kb + (row0 + 64 * i + lane) * KVW + kvh * 64 + w * 8), (LAS unsigned*)(blk + w * AT_KSTR + i * 1024), 16, 0, 0);
        const int p = 2 * w + i, dh = p >> 3, kg = p & 7;
        __builtin_amdgcn_global_load_lds((const GAS unsigned*)(Vb + (row0 + 16 * kg + (lane >> 2)) * KVW + kvh * 64 + dh * 32 + (lane & 3) * 8), (LAS unsigned*)(blk + AT_VOFF + dh * AT_VDH + kg * 1024), 16, 0, 0); }
}
__device__ __forceinline__ void attn_prompt_unit(Frame& F, int gid, int lane) {
    const int r32 = lane & 31, hi = lane >> 5, wid = F.wave;
    const bf16* Qb = (const bf16*)(F.ws + WS_Q); const bf16* SG = (const bf16*)(F.ws + WS_SG); bf16* OG = (bf16*)(F.ws + WS_OG);
    const int bk = gid >> 4, kvh = bk & 3, b = bk >> 2, qb = gid & 15;
    const int head = kvh * 8 + wid; const size_t rowbase = (size_t)b * SEQ; const int t0 = qb * 128;
    LAS unsigned char* lds = F.lds;
    const unsigned tboff = (unsigned)AT_BT + (unsigned)(wid & 7) * AT_BTW + (((unsigned)lane & 31u) + 4u * (1u - (((unsigned)lane >> 5) & 1u))) * 4u;
    LAS float* wsf = (LAS float*)(lds + AT_WS) + wid * 64;
    LAS unsigned short* stg = (LAS unsigned short*)(lds + AT_OST + wid * 4096);
    const float sinkv = F.sk[head] * LOG2E;
    const int slotc = (gid % 3) * AT_BLK, slotp = ((gid + 2) % 3) * AT_BLK;
    const int vlane = (4 * hi + ((lane & 15) >> 2)) * 64 + ((lane >> 4) & 1) * 32 + (lane & 3) * 8;
    const int ktmin = (qb == 0) ? 4 : 0;
    const bf16* Qw = Qb + (rowbase + t0 + r32) * AW + head * 64 + hi * 8;
    bf16x8 qr[4];
#pragma unroll
    for (int d0 = 0; d0 < 4; ++d0) qr[d0] = *(const GAS bf16x8*)(Qw + d0 * 16);
    for (int qt = 0; qt < 4; ++qt) {
        f32x16 p[5];
        float mx0 = sinkv, mx1 = sinkv, mx2 = sinkv, mx3 = sinkv;
        unsigned tbo = tboff; asm volatile("" : "+v"(tbo));
#pragma unroll
        for (int j = 0; j < 5; ++j) { const int kt = qt + j;
            f32x16 a;
#pragma unroll
            for (int r = 0; r < 16; ++r) a[r] = *(const LAS float*)(lds + tbo + 4 * (159 - 32 * j - ((r & 3) + 8 * (r >> 2))));
            if (kt >= ktmin) {
                const LAS unsigned char* kb = lds + ((kt >> 2) ? slotc : slotp) + hi * AT_KSTR + ((kt & 3) * 32 + r32) * 16;
#pragma unroll
                for (int d0 = 0; d0 < 4; ++d0) { const bf16x8 kf = *(const LAS bf16x8*)(kb + 2 * d0 * AT_KSTR); a = MFMA32(kf, qr[d0], a); }
            } else {
#pragma unroll
                for (int r = 0; r < 16; ++r) a[r] = NEGBIG;
            }
#pragma unroll
            for (int r = 0; r < 16; r += 4) { mx0 = fmaxf(mx0, a[r]); mx1 = fmaxf(mx1, a[r + 1]); mx2 = fmaxf(mx2, a[r + 2]); mx3 = fmaxf(mx3, a[r + 3]); }
            p[j] = a; }
        asm volatile("" ::: "memory");
        if (qt < 3) {
#pragma unroll
            for (int d0 = 0; d0 < 4; ++d0) qr[d0] = *(const GAS bf16x8*)(Qw + (size_t)(qt + 1) * 32 * AW + d0 * 16); }
        v4u gv[4];
#pragma unroll
        for (int i = 0; i < 4; ++i) gv[i] = *(const GAS v4u*)(SG + (rowbase + t0 + qt * 32 + i * 8 + (lane >> 3)) * AW + head * 64 + (lane & 7) * 8);
        asm volatile("" ::: "memory");
        const float mx = half_swap_max(fmaxf(fmaxf(mx0, mx1), fmaxf(mx2, mx3)));
        float l0 = 0.f, l1 = 0.f, l2 = 0.f, l3 = 0.f;
        bf16x8 pa[5][2];
#pragma unroll
        for (int j = 0; j < 5; ++j) {
#pragma unroll
            for (int r = 0; r < 16; r += 4) { const float e0 = __builtin_amdgcn_exp2f(p[j][r] - mx), e1 = __builtin_amdgcn_exp2f(p[j][r + 1] - mx), e2 = __builtin_amdgcn_exp2f(p[j][r + 2] - mx), e3 = __builtin_amdgcn_exp2f(p[j][r + 3] - mx);
                p[j][r] = e0; p[j][r + 1] = e1; p[j][r + 2] = e2; p[j][r + 3] = e3; l0 += e0; l1 += e1; l2 += e2; l3 += e3; }
            pa[j][0] = pack8(p[j], 0); pa[j][1] = pack8(p[j], 1); }
        const float l = half_swap_sum((l0 + l1) + (l2 + l3)) + __builtin_amdgcn_exp2f(sinkv - mx);
        f32x16 o[2]; o[0] = f32x16{}; o[1] = f32x16{};
#pragma unroll
        for (int j = 0; j < 5; ++j) { const int kt = qt + j;
            if (kt >= ktmin) {
                const LAS unsigned char* vb = lds + ((kt >> 2) ? slotc : slotp) + AT_VOFF + (kt & 3) * 2048 + vlane;
#pragma unroll
                for (int s = 0; s < 2; ++s) {
#pragma unroll
                    for (int d0 = 0; d0 < 2; ++d0) { const LAS unsigned char* vp = vb + d0 * AT_VDH + s * 1024;
                        const s16x4 lo = vtr(vp), hh = vtr(vp + 512); o[d0] = MFMA32(pa[j][s], cat44(lo, hh), o[d0]); } } } }
        if (hi == 0) wsf[32 + r32] = l;
        LDS_WAIT(); asm volatile("" ::: "memory");
#pragma unroll
        for (int r = 0; r < 16; ++r) { const int orow = crow(r, hi); const float rl = __builtin_amdgcn_rcpf(wsf[32 + orow]);
            stg[orow * 64 + r32] = (unsigned short)f2bf(o[0][r] * rl); stg[orow * 64 + 32 + r32] = (unsigned short)f2bf(o[1][r] * rl); }
        LDS_WAIT(); asm volatile("" ::: "memory");
#pragma unroll
        for (int i = 0; i < 4; ++i) { const int row = i * 8 + (lane >> 3), ch = lane & 7; const v4u ov = *(const LAS v4u*)(stg + row * 64 + ch * 8);
            const size_t gi = (rowbase + t0 + qt * 32 + row) * AW + head * 64 + ch * 8; v4u w;
            w.x = pk2(bflo(ov.x) * bflo(gv[i].x), bfhi(ov.x) * bfhi(gv[i].x)); w.y = pk2(bflo(ov.y) * bflo(gv[i].y), bfhi(ov.y) * bfhi(gv[i].y));
            w.z = pk2(bflo(ov.z) * bflo(gv[i].z), bfhi(ov.z) * bfhi(gv[i].z)); w.w = pk2(bflo(ov.w) * bflo(gv[i].w), bfhi(ov.w) * bfhi(gv[i].w));
            *(GAS v4u*)(OG + gi) = w; }
        LDS_WAIT(); asm volatile("" ::: "memory");
    }
}
__device__ __forceinline__ void p2_prompt_attention(Frame& F) {
    const int lane = lane_id();
    const int per = (1024 + F.G - 1) / F.G, u0 = F.vcu * per, u1 = (u0 + per < 1024) ? u0 + per : 1024;
    if (u0 >= u1) return;
    const float* BT = (const float*)(F.ws + WS_BT);
    if ((u0 & 15) != 0) attn_dma_block(F, u0 - 1, lane);
    attn_dma_block(F, u0, lane);
    int head_cur = -1;
    for (int u = u0; u < u1; ++u) {
        const int head = ((u >> 4) & 3) * 8 + F.wave;
        if (head != head_cur) { head_cur = head; LAS float* tbw = (LAS float*)(F.lds + AT_BT + F.wave * AT_BTW);
#pragma unroll
            for (int i = 0; i < 4; ++i) { const int k = lane + 64 * i, rel = k - 35; if (k < 200) tbw[k] = (rel >= 0 && rel < 128) ? BT[head * 128 + rel] : NEGBIG; } }
        asm volatile("s_waitcnt vmcnt(0) lgkmcnt(0)" ::: "memory"); __syncthreads();
        if (u + 1 < u1) attn_dma_block(F, u + 1, lane);
        attn_prompt_unit(F, u, lane);
    }
    asm volatile("s_waitcnt vmcnt(0) lgkmcnt(0)" ::: "memory"); __syncthreads();
}

constexpr int AS_K = 0, AS_V = 33280, AS_Q = 66048, AS_P = 68096;
__device__ __forceinline__ void attn_sample_unit(Frame& F, int s, int kvh) {
    const int tid = cur_tid(F), lane = lane_id(), wid = F.wave;
    LAS float* Kf = (LAS float*)(F.lds + AS_K); LAS float* Vf = (LAS float*)(F.lds + AS_V); LAS float* qf = (LAS float*)(F.lds + AS_Q) + wid * 64; LAS float* pb = (LAS float*)(F.lds + AS_P) + wid * 128;
    const bf16* Qb = (const bf16*)(F.ws + WS_Q); const bf16* SG = (const bf16*)(F.ws + WS_SG); bf16* OG = (bf16*)(F.ws + WS_OG); const float* BT = (const float*)(F.ws + WS_BT);
    const int head = kvh * 8 + wid; const size_t row = (size_t)MPR + s;
#pragma unroll
    for (int i = 0; i < 4; ++i) { const int idx = tid + 512 * i, jj = idx >> 4, c4 = idx & 15;
        const float* ksrc = (jj < 127) ? F.ck + ((size_t)(s * 128 + jj + 1) * 4 + kvh) * 64 : F.out + O_KS + ((size_t)(s * 128 + 127) * 4 + kvh) * 64;
        const float* vsrc = (jj < 127) ? F.cv + ((size_t)(s * 128 + jj + 1) * 4 + kvh) * 64 : F.out + O_VS + ((size_t)(s * 128 + 127) * 4 + kvh) * 64;
        const f32x4 kv = *(const GAS f32x4*)(ksrc + c4 * 4), vv = *(const GAS f32x4*)(vsrc + c4 * 4);
        Kf[jj * 65 + c4 * 4 + 0] = kv[0]; Kf[jj * 65 + c4 * 4 + 1] = kv[1]; Kf[jj * 65 + c4 * 4 + 2] = kv[2]; Kf[jj * 65 + c4 * 4 + 3] = kv[3];
        *(LAS f32x4*)(Vf + jj * 64 + c4 * 4) = vv; }
    qf[lane] = bf2f(Qb[row * AW + head * 64 + lane]);
    __syncthreads();
    float s0 = 0.f, s1 = 0.f;
#pragma unroll 8
    for (int d = 0; d < 64; ++d) { const float q = qf[d]; s0 += q * Kf[lane * 65 + d]; s1 += q * Kf[(lane + 64) * 65 + d]; }
    s0 += BT[head * 128 + 127 - lane]; s1 += BT[head * 128 + 63 - lane];
    const float sinkv = F.sk[head] * LOG2E;
    const float mx = fmaxf(wave_max(fmaxf(s0, s1)), sinkv);
    const float p0 = __builtin_amdgcn_exp2f(s0 - mx), p1 = __builtin_amdgcn_exp2f(s1 - mx);
    const float l = wave_sum(p0 + p1) + __builtin_amdgcn_exp2f(sinkv - mx);
    pb[lane] = p0; pb[lane + 64] = p1;
    LDS_WAIT(); asm volatile("" ::: "memory");
    float o = 0.f;
#pragma unroll 8
    for (int jj = 0; jj < 128; ++jj) o += pb[jj] * Vf[jj * 64 + lane];
    const size_t gi = row * AW + head * 64 + lane;
    OG[gi] = (unsigned short)f2bf(o / l * bf2f(SG[gi]));
    __syncthreads();
}
__device__ __forceinline__ void p2_attention(Frame& F) {
    p2_prompt_attention(F);
#ifndef DUP_AS
#define DUP_AS 1
#endif
    for (int rep = 0; rep < DUP_AS; ++rep)
    for (int u = F.vcu; u < NS * 4; u += F.G) attn_sample_unit(F, u >> 2, u & 3);
}

__device__ __forceinline__ unsigned off_a(unsigned row, unsigned ch) { return 2048u * (row >> 3) + 512u * (ch >> 2) + 64u * (row & 7) + 16u * ((ch & 3) ^ ((row >> 2) & 3)); }
__device__ __forceinline__ unsigned tr_base(unsigned lane, unsigned t) {
    const unsigned h = lane >> 5, blk = (lane >> 4) & 1, q = (lane & 15) >> 2, p = lane & 3;
    return 2048u * h + 64u * (4 * t + q) + 16u * ((2 * blk + (p >> 1)) ^ (2 * h + t)) + 8u * (p & 1);
}
constexpr int RT_QS = 528;
constexpr int RT_Q = 0, RT_K = 33792, RT_V = 66560, RT_P = 82944, RT_X = 92160, RT_O = 124928, RT_END = 141312;
constexpr int RT_PS = 144;
static_assert(RT_END <= LDS_BYTES, "retention LDS");
constexpr int RC = 64;

__device__ __forceinline__ void ret_sample_unit(Frame& F, int s, int h);
__device__ __forceinline__ void ret_prompt_unit(Frame& F, int b, int h, int es, int su0, int ss0, int su1, int ss1) {
    int tid_ = cur_tid(F); asm volatile("" : "+v"(tid_));
    const int tid = tid_, lane = tid & 63, r32 = lane & 31, hi = lane >> 5, wid = F.wave, ec = wid & 3, dh = wid >> 2;
    LAS unsigned char* lds = F.lds;
    const bf16* Qr = (const bf16*)(F.ws + WS_Q); const bf16* Kr = Qr + (size_t)MPAD * DM; const bf16* Vr = (const bf16*)(F.ws + WS_SG);
    bf16* ORAW = (bf16*)(F.ws + WS_ORAW); float* STAT = (float*)(F.ws + WS_STAT);
    const size_t rowbase = (size_t)b * SEQ;
    const float gam = 1.0f - exp2f(-5.0f - (float)h);
    const float gCm1 = exp2f(log2f(gam) * (float)(RC - 1));
    f32x16 R[4];
#pragma unroll
    for (int dt = 0; dt < 4; ++dt) R[dt] = f32x16{};
    v4u sq[4], sk[4], sv[2];
    const int qrow = tid >> 5, qch = tid & 31;
    const int vrow = tid >> 4, vch = tid & 15;
#define RT_LOAD(step) do { const size_t tok0_ = rowbase + (size_t)(step) * RC; \
    _Pragma("unroll") for (int i_ = 0; i_ < 4; ++i_) { const size_t g_ = (tok0_ + qrow + 16 * i_) * DM + h * 256 + qch * 8; sq[i_] = *(const GAS v4u*)(Qr + g_); sk[i_] = *(const GAS v4u*)(Kr + g_); } \
    _Pragma("unroll") for (int i_ = 0; i_ < 2; ++i_) sv[i_] = *(const GAS v4u*)(Vr + (tok0_ + vrow + 32 * i_) * AW + h * 512 + es * 128 + vch * 8); } while (0)
#define RT_WRITE() do { \
    _Pragma("unroll") for (int i_ = 0; i_ < 4; ++i_) { const int row_ = qrow + 16 * i_; *(LAS v4u*)(lds + RT_Q + row_ * RT_QS + qch * 16) = sq[i_]; \
        *(LAS v4u*)(lds + RT_K + (qch >> 4) * 16384 + off_a(row_, qch & 15)) = sk[i_]; } \
    _Pragma("unroll") for (int i_ = 0; i_ < 2; ++i_) { const int row_ = vrow + 32 * i_; *(LAS v4u*)(lds + RT_V + off_a(row_, vch)) = sv[i_]; } } while (0)
#define RT_FLUSH(stp) do { LAS unsigned short* stg = (LAS unsigned short*)(lds + RT_O + wid * 2048); \
            const int orow = lane >> 1, half = lane & 1; \
            const v4u a0 = *(const LAS v4u*)(stg + orow * 32 + half * 16), a1 = *(const LAS v4u*)(stg + orow * 32 + half * 16 + 8); \
            float sm = 0.f, s2m = 0.f; \
            RT_ACC(a0.x); RT_ACC(a0.y); RT_ACC(a0.z); RT_ACC(a0.w); RT_ACC(a1.x); RT_ACC(a1.y); RT_ACC(a1.z); RT_ACC(a1.w); \
            sm += __shfl_xor(sm, 1); s2m += __shfl_xor(s2m, 1); \
            const size_t grow = rowbase + (size_t)(stp) * RC + 32 * dh + orow; \
            bf16* op = ORAW + grow * AW + h * 512 + es * 128 + ec * 32 + half * 16; \
            *(GAS v4u*)op = a0; *(GAS v4u*)(op + 8) = a1; \
            STAT[((grow * 4 + h) * 16 + es * 4 + ec) * 2 + half] = half ? s2m : sm; } while (0)
#define RT_ACC(w) do { const float x0_ = bflo(w), x1_ = bfhi(w); sm += x0_ + x1_; s2m += x0_ * x0_ + x1_ * x1_; } while (0)
    RT_LOAD(0);
    const int NSTEP = SEQ / RC;
    for (int step = 0; step < NSTEP; ++step) {
        RT_WRITE();
        __syncthreads();
        if (step > 0) RT_FLUSH(step - 1);
        RT_LOAD((step + 1 < NSTEP) ? step + 1 : step);
        const unsigned k16 = 2048u * ((lane & 15) >> 3) + 64u * (lane & 7) + 16u * ((lane >> 4) ^ (((lane & 15) >> 2) & 3));
#pragma unroll
        for (int tt = 0; tt < 2; ++tt) { const int T = 2 * wid + tt, jt = T >> 2, it = T & 3; const int l15 = lane & 15, g = lane >> 4;
            f32x4 a = {0.f, 0.f, 0.f, 0.f};
            if (jt <= it) {
#pragma unroll
                for (int s = 0; s < 8; ++s) {
                    const bf16x8 ka = *(const LAS bf16x8*)(lds + RT_K + k16 + 4096 * jt + (s >> 2) * 16384 + 512 * (s & 3));
                    const bf16x8 qb = *(const LAS bf16x8*)(lds + RT_Q + (16 * it + l15) * RT_QS + (32 * s + 8 * g) * 2);
                    a = MFMA16(ka, qb, a); }
            }
            const int i = 16 * it + l15, j0 = 16 * jt + 4 * g;
            v2u w; w.x = pk2((i >= j0) ? a[0] : 0.f, (i >= j0 + 1) ? a[1] : 0.f); w.y = pk2((i >= j0 + 2) ? a[2] : 0.f, (i >= j0 + 3) ? a[3] : 0.f);
            *(LAS v2u*)(lds + RT_P + i * RT_PS + j0 * 2) = w; }
        __builtin_amdgcn_sched_barrier(0);
        f32x16 part;
#pragma unroll
        for (int pass = 0; pass < 2; ++pass) { const int it = (pass == 0) ? (1 - dh) : dh;
            part = f32x16{};
#pragma unroll
            for (int dt = 0; dt < 4; ++dt)
#pragma unroll
                for (int s2 = 0; s2 < 2; ++s2) { const bf16x8 rb = pack8(R[dt], s2); const int dcol = 128 * dh + 32 * dt + 16 * s2 + 4 * hi;
                    const LAS unsigned char* qp = lds + RT_Q + (32 * it + r32) * RT_QS + dcol * 2;
                    const s16x4 lo = *(const LAS s16x4*)qp, hh = *(const LAS s16x4*)(qp + 16);
                    part = MFMA32(cat44(lo, hh), rb, part); }
            if (pass == 0) { LAS float* xo = (LAS float*)(lds + RT_X + wid * 4096);
#pragma unroll
                for (int r = 0; r < 16; ++r) xo[r * 64 + lane] = part[r];
                __builtin_amdgcn_sched_barrier(0); } }
        __syncthreads();
        const unsigned trb0 = tr_base(lane, 0), trb1 = tr_base(lane, 1);
        bf16x8 vf[4];
#pragma unroll
        for (int ks = 0; ks < 4; ++ks) vf[ks] = cat44(vtr(lds + RT_V + trb0 + 512 * ec + 4096 * ks), vtr(lds + RT_V + trb1 + 512 * ec + 4096 * ks));
        __builtin_amdgcn_sched_barrier(0);
        f32x16 oi = f32x16{};
#pragma unroll
        for (int jt = 0; jt < 2; ++jt) if (jt <= dh) {
#pragma unroll
            for (int s2 = 0; s2 < 2; ++s2) { const bf16x8 pa = *(const LAS bf16x8*)(lds + RT_P + (32 * dh + r32) * RT_PS + (32 * jt + 16 * s2 + 8 * hi) * 2);
                oi = MFMA32(pa, vf[2 * jt + s2], oi); } }
        __builtin_amdgcn_sched_barrier(0);
        {   const LAS float* xi = (const LAS float*)(lds + RT_X + (wid ^ 4) * 4096);
            LAS unsigned short* stg = (LAS unsigned short*)(lds + RT_O + wid * 2048);
#pragma unroll
            for (int r = 0; r < 16; ++r) {
                const float inter = part[r] + xi[r * 64 + lane];
                const float v = oi[r] + gam * inter;
                stg[crow(r, hi) * 32 + r32] = (unsigned short)f2bf(v); }
        }
        __builtin_amdgcn_sched_barrier(0);
#pragma unroll
        for (int dt = 0; dt < 4; ++dt)
#pragma unroll
            for (int r = 0; r < 16; ++r) R[dt][r] *= gam;
#pragma unroll
        for (int ks = 0; ks < 4; ++ks) { const LAS unsigned char* kb = lds + RT_K + dh * 16384;
            const bf16x8 vk = cat44(vtr(lds + RT_V + trb0 + 512 * ec + 4096 * ks), vtr(lds + RT_V + trb1 + 512 * ec + 4096 * ks));
#pragma unroll
            for (int dt = 0; dt < 4; ++dt) { const bf16x8 kf = cat44(vtr(kb + trb0 + 512 * dt + 4096 * ks), vtr(kb + trb1 + 512 * dt + 4096 * ks));
                R[dt] = MFMA32(kf, vk, R[dt]); } }
#pragma unroll
        for (int dt = 0; dt < 4; ++dt)
#pragma unroll
            for (int r = 0; r < 16; ++r) R[dt][r] *= gCm1;
        __syncthreads();
        if (step == ss0) ret_sample_unit(F, su0 >> 2, su0 & 3);
        if (step == ss1) ret_sample_unit(F, su1 >> 2, su1 & 3);
    }
    RT_FLUSH(NSTEP - 1);
#undef RT_FLUSH
#undef RT_ACC
    const int lane2 = lane_id();
    float* rp = F.out + O_RP + ((size_t)(b * 4 + h) * 256 + 128 * dh + 4 * (lane2 >> 5)) * 512 + es * 128 + ec * 32 + (lane2 & 31);
#pragma unroll
    for (int dt = 0; dt < 4; ++dt)
#pragma unroll
        for (int r = 0; r < 16; ++r) rp[(size_t)(32 * dt + (r & 3) + 8 * (r >> 2)) * 512] = R[dt][r];
#undef RT_LOAD
#undef RT_WRITE
}

constexpr int RS_Q = 0, RS_K = 1024, RS_RED = 2048, RS_ST = 2048 + 8192;
__device__ __forceinline__ void ret_sample_unit(Frame& F, int s, int h) {
    const int tid = cur_tid(F), lane = lane_id(), wid = F.wave;
    const bf16* Qr = (const bf16*)(F.ws + WS_Q); const bf16* Kr = Qr + (size_t)MPAD * DM; const bf16* Vr = (const bf16*)(F.ws + WS_SG); const bf16* SG2 = (const bf16*)(F.ws + WS_OG);
    bf16* OG2 = (bf16*)(F.ws + WS_ORAW);
    LAS float* qf = (LAS float*)(F.lds + RS_Q); LAS float* kf = (LAS float*)(F.lds + RS_K); LAS float* red = (LAS float*)(F.lds + RS_RED); LAS float* stt = (LAS float*)(F.lds + RS_ST);
    const size_t row = (size_t)MPR + s;
    const float gamma = 1.0f - exp2f(-5.0f - (float)h);
    if (tid < 256) { qf[tid] = bf2f(Qr[row * DM + h * 256 + tid]); kf[tid] = bf2f(Kr[row * DM + h * 256 + tid]); }
    __syncthreads();
    float qk = 0.f;
#pragma unroll
    for (int i = 0; i < 4; ++i) qk += qf[lane + 64 * i] * kf[lane + 64 * i];
    qk = wave_sum(qk);
    const int e4 = tid & 127, dg = tid >> 7;
    const v2u vw = *(const GAS v2u*)(Vr + row * AW + h * 512 + e4 * 4);
    const f32x4 v = {bflo(vw.x), bfhi(vw.x), bflo(vw.y), bfhi(vw.y)};
    const float* Rin = F.st + ((size_t)(s * 4 + h) * 256) * 512 + e4 * 4; float* Rout = F.out + O_RS + ((size_t)(s * 4 + h) * 256) * 512 + e4 * 4;
    f32x4 acc = {0.f, 0.f, 0.f, 0.f};
#pragma unroll 8
    for (int i = 0; i < 64; ++i) { const int d = dg + 4 * i; const f32x4 r = *(const GAS f32x4*)(Rin + (size_t)d * 512);
        const float kd = kf[d], qd = qf[d];
        *(GAS f32x4*)(Rout + (size_t)d * 512) = r * gamma + v * kd; acc += r * qd; }
    *(LAS f32x4*)(red + dg * 512 + e4 * 4) = acc;
    __syncthreads();
    float o[4] = {0.f, 0.f, 0.f, 0.f}; float sm = 0.f, s2m = 0.f;
    if (tid < 128) {
        const f32x4 t0 = *(const LAS f32x4*)(red + e4 * 4), t1 = *(const LAS f32x4*)(red + 512 + e4 * 4), t2 = *(const LAS f32x4*)(red + 1024 + e4 * 4), t3 = *(const LAS f32x4*)(red + 1536 + e4 * 4);
#pragma unroll
        for (int j = 0; j < 4; ++j) { o[j] = qk * v[j] + gamma * ((t0[j] + t1[j]) + (t2[j] + t3[j])); sm += o[j]; s2m += o[j] * o[j]; }
        sm = wave_sum(sm); s2m = wave_sum(s2m);
        if (lane == 0) { stt[wid * 2] = sm; stt[wid * 2 + 1] = s2m; }
    }
    __syncthreads();
    if (tid < 128) {
        const float S = stt[0] + stt[2], S2 = stt[1] + stt[3]; const float mu = S * (1.f / 512.f), var = fmaxf(S2 * (1.f / 512.f) - mu * mu, 0.f), rstd = 1.0f / sqrtf(var + EPS);
        const size_t gi = row * AW + h * 512 + e4 * 4; const v2u gw = *(const GAS v2u*)(SG2 + gi);
        v2u w; w.x = pk2((o[0] - mu) * rstd * bflo(gw.x), (o[1] - mu) * rstd * bfhi(gw.x)); w.y = pk2((o[2] - mu) * rstd * bflo(gw.y), (o[3] - mu) * rstd * bfhi(gw.y));
        *(GAS v2u*)(OG2 + gi) = w;
    }
    __syncthreads();
}
__device__ __forceinline__ void p5_retention(Frame& F) {
    if (F.G == 256) {
        const int v = F.vcu;
        ret_prompt_unit(F, v >> 4, (v >> 2) & 3, v & 3, v, (5 * v) & 31, v + 256, (5 * v + 16) & 31);
    } else {
        for (int u = F.vcu; u < 256; u += F.G) ret_prompt_unit(F, u >> 4, (u >> 2) & 3, u & 3, 0, -1, 0, -1);
        for (int u = F.vcu; u < NS * 4; u += F.G) ret_sample_unit(F, u >> 2, u & 3);
    }
}
__device__ __forceinline__ void p5b_normalize(Frame& F) {
    const int gw = F.vcu * NWAVES + F.wave, NGW = F.G * NWAVES, lane = lane_id();
    bf16* ORAW = (bf16*)(F.ws + WS_ORAW); const bf16* SG2 = (const bf16*)(F.ws + WS_OG); const float* STAT = (const float*)(F.ws + WS_STAT);
    for (int m = gw; m < MPR; m += NGW) {
#pragma unroll
        for (int hh = 0; hh < 4; ++hh) {
            const GAS f32x4* sp = (const GAS f32x4*)(STAT + ((size_t)m * 4 + hh) * 32); float S = 0.f, S2 = 0.f;
#pragma unroll
            for (int i = 0; i < 8; ++i) { const f32x4 t = sp[i]; S += t[0] + t[2]; S2 += t[1] + t[3]; }
            const float mu = S * (1.f / 512.f), var = fmaxf(S2 * (1.f / 512.f) - mu * mu, 0.f), rstd = 1.0f / sqrtf(var + EPS);
            const size_t gi = (size_t)m * AW + hh * 512 + lane * 8; const v4u ov = *(const GAS v4u*)(ORAW + gi), gv = *(const GAS v4u*)(SG2 + gi); v4u w;
#define NRM(o_, g_) pk2((bflo(o_) - mu) * rstd * bflo(g_), (bfhi(o_) - mu) * rstd * bfhi(g_))
            w.x = NRM(ov.x, gv.x); w.y = NRM(ov.y, gv.y); w.z = NRM(ov.z, gv.z); w.w = NRM(ov.w, gv.w);
#undef NRM
            *(GAS v4u*)(ORAW + gi) = w; }
    }
}
__device__ __forceinline__ void p7_final_norm(Frame& F) {
    const int gw = F.vcu * NWAVES + F.wave, NGW = F.G * NWAVES, lane = lane_id();
    for (int m = gw; m < MV; m += NGW) {
        float* rowp = (m < MPR) ? F.out + O_YP + (size_t)m * DM : F.out + O_YS + (size_t)(m - MPR) * DM;
        GAS f32x4* xr = (GAS f32x4*)rowp + lane; const GAS f32x4* gr = (const GAS f32x4*)F.fg + lane;
        f32x4 v[4]; float s = 0.f;
#pragma unroll
        for (int j = 0; j < 4; ++j) { v[j] = xr[64 * j]; s += (v[j].x * v[j].x + v[j].y * v[j].y) + (v[j].z * v[j].z + v[j].w * v[j].w); }
        const float rstd = 1.0f / sqrtf(wave_sum(s) * (1.f / DM) + EPS);
#pragma unroll
        for (int j = 0; j < 4; ++j) xr[64 * j] = v[j] * rstd * gr[64 * j];
    }
}

template <int K>
__device__ __forceinline__ void sgemm_unit(const bf16* A, int lda, const bf16* Bt, int n0, int n1, int wave, int lane, f32x4& c0, f32x4& c1) {
    const int l15 = lane & 15, g = lane >> 4;
    const bf16* ap = A + (size_t)(16 * wave + l15) * lda + 8 * g;
    const bf16* b0 = Bt + (size_t)(n0 + l15) * K + 8 * g; const bf16* b1 = Bt + (size_t)(n1 + l15) * K + 8 * g;
    c0 = f32x4{0.f, 0.f, 0.f, 0.f}; c1 = f32x4{0.f, 0.f, 0.f, 0.f};
#pragma unroll 8
    for (int s = 0; s < K / 32; ++s) { const bf16x8 a = *(const GAS bf16x8*)(ap + 32 * s), x = *(const GAS bf16x8*)(b0 + 32 * s), y = *(const GAS bf16x8*)(b1 + 32 * s);
        c0 = MFMA16(a, x, c0); c1 = MFMA16(a, y, c1); }
}
__device__ __forceinline__ void p1_sample(Frame& F) {
    const int lane = lane_id(), l15 = lane & 15, g = lane >> 4;
    const bf16* XN = (const bf16*)(F.ws + WS_XN) + (size_t)MPR * DM; const bf16* W = (const bf16*)(F.ws + WS_WINA);
    bf16* Q = (bf16*)(F.ws + WS_Q); bf16* SG = (bf16*)(F.ws + WS_SG);
    for (int u = F.vcu; u < ATT_IN / 32; u += F.G) { f32x4 c[2]; const int n0 = 32 * u;
        sgemm_unit<DM>(XN, DM, W, n0, n0 + 16, F.wave, lane, c[0], c[1]);
#pragma unroll
        for (int t = 0; t < 2; ++t) { const int col = n0 + 16 * t + l15;
#pragma unroll
            for (int r = 0; r < 4; ++r) { const int s = 16 * F.wave + 4 * g + r; const float v = c[t][r]; const size_t row = (size_t)MPR + s;
                if (col < 2048) Q[row * AW + col] = (unsigned short)f2bf(v * C2);
                else if (col < 2304) F.out[O_KS + (size_t)(s * 128 + 127) * 256 + (col - 2048)] = v;
                else if (col < 2560) F.out[O_VS + (size_t)(s * 128 + 127) * 256 + (col - 2304)] = v;
                else SG[row * AW + (col - 2560)] = (unsigned short)f2bf(silu_f(v)); } } }
}
__device__ __forceinline__ void p3_sample(Frame& F) {
    const int lane = lane_id(), l15 = lane & 15, g = lane >> 4;
    const bf16* OG = (const bf16*)(F.ws + WS_OG) + (size_t)MPR * AW; const bf16* W = (const bf16*)(F.ws + WS_WOA);
    float* X1 = (float*)(F.ws + WS_X1); bf16* XN2 = (bf16*)(F.ws + WS_XN); float* SSQS = (float*)(F.ws + WS_SSQ1) + (size_t)MPR * 16;
    for (int u = F.vcu; u < DM / 32; u += F.G) { f32x4 c[2]; const int n0 = 32 * u;
        sgemm_unit<AW>(OG, AW, W, n0, n0 + 16, F.wave, lane, c[0], c[1]);
#pragma unroll
        for (int t = 0; t < 2; ++t) { const int col = n0 + 16 * t + l15;
#pragma unroll
            for (int r = 0; r < 4; ++r) { const int s = 16 * F.wave + 4 * g + r; const size_t row = (size_t)MPR + s;
                const float x1 = F.xs[(size_t)s * DM + col] + c[t][r]; X1[row * DM + col] = x1; XN2[row * DM + col] = (unsigned short)f2bf(x1);
                float sq = x1 * x1; sq += __shfl_xor(sq, 1); sq += __shfl_xor(sq, 2); sq += __shfl_xor(sq, 4); sq += __shfl_xor(sq, 8);
                if (l15 == 0) SSQS[s * 64 + 2 * u + t] = sq; } } }
}
__device__ __forceinline__ void p4_sample(Frame& F) {
    const int lane = lane_id(), l15 = lane & 15, g = lane >> 4;
    const bf16* XN2 = (const bf16*)(F.ws + WS_XN) + (size_t)MPR * DM; const bf16* W = (const bf16*)(F.ws + WS_WINR);
    const float* SSQS = (const float*)(F.ws + WS_SSQ1) + (size_t)MPR * 16; const float* COS = (const float*)(F.ws + WS_COS) + 2048 * 128; const float* SIN = (const float*)(F.ws + WS_SIN) + 2048 * 128;
    bf16* Qr = (bf16*)(F.ws + WS_Q); bf16* Kr = Qr + (size_t)MPAD * DM; bf16* Vr = (bf16*)(F.ws + WS_SG); bf16* SG2 = (bf16*)(F.ws + WS_OG);
    for (int u = F.vcu; u < 192; u += F.G) {
        float rstd[4];
#pragma unroll
        for (int r = 0; r < 4; ++r) { const int s = 16 * F.wave + 4 * g + r; const GAS f32x4* sp = (const GAS f32x4*)(SSQS + s * 64) + (l15 & 3) * 4; float a = 0.f;
#pragma unroll
            for (int i = 0; i < 4; ++i) { const f32x4 t = sp[i]; a += (t[0] + t[1]) + (t[2] + t[3]); }
            a += __shfl_xor(a, 1); a += __shfl_xor(a, 2); rstd[r] = 1.0f / sqrtf(a * (1.f / DM) + EPS); }
        f32x4 c0, c1;
        if (u < 64) { const int hq = u >> 3, j = u & 7, n0 = 256 * hq + 16 * j, d = 16 * j + l15;
            sgemm_unit<DM>(XN2, DM, W, n0, n0 + 128, F.wave, lane, c0, c1);
            const float cc = COS[d], ss = SIN[d], sc = (hq < 4) ? 1.0f : 0.0625f; bf16* dst = (hq < 4) ? Qr : Kr;
#pragma unroll
            for (int r = 0; r < 4; ++r) { const int s = 16 * F.wave + 4 * g + r; const size_t row = (size_t)MPR + s; const float x1 = c0[r] * rstd[r] * sc, x2 = c1[r] * rstd[r] * sc;
                dst[row * DM + (hq & 3) * 256 + d] = (unsigned short)f2bf(x1 * cc - x2 * ss); dst[row * DM + (hq & 3) * 256 + 128 + d] = (unsigned short)f2bf(x1 * ss + x2 * cc); }
        } else { const int n0 = 2048 + 32 * (u - 64);
            sgemm_unit<DM>(XN2, DM, W, n0, n0 + 16, F.wave, lane, c0, c1);
#pragma unroll
            for (int t = 0; t < 2; ++t) { const int col = n0 + 16 * t + l15;
#pragma unroll
                for (int r = 0; r < 4; ++r) { const int s = 16 * F.wave + 4 * g + r; const size_t row = (size_t)MPR + s; const float v = (t == 0 ? c0[r] : c1[r]) * rstd[r];
                    if (col < 4096) Vr[row * AW + (col - 2048)] = (unsigned short)f2bf(v); else SG2[row * AW + (col - 4096)] = (unsigned short)f2bf(silu_f(v)); } } }
    }
}
__device__ __forceinline__ void p6_sample(Frame& F) {
    const int lane = lane_id(), l15 = lane & 15, g = lane >> 4;
    const bf16* OG2 = (const bf16*)(F.ws + WS_ORAW) + (size_t)MPR * AW; const bf16* W = (const bf16*)(F.ws + WS_WOR); const float* X1 = (const float*)(F.ws + WS_X1);
    for (int u = F.vcu; u < DM / 32; u += F.G) { f32x4 c[2]; const int n0 = 32 * u;
        sgemm_unit<AW>(OG2, AW, W, n0, n0 + 16, F.wave, lane, c[0], c[1]);
#pragma unroll
        for (int t = 0; t < 2; ++t) { const int col = n0 + 16 * t + l15;
#pragma unroll
            for (int r = 0; r < 4; ++r) { const int s = 16 * F.wave + 4 * g + r; F.out[O_YS + (size_t)s * DM + col] = X1[((size_t)MPR + s) * DM + col] + c[t][r]; } } }
}

__device__ __forceinline__ void grid_bar(const Frame& F, unsigned* cnt, unsigned target) {
    asm volatile("s_waitcnt vmcnt(0)" ::: "memory");
    __syncthreads();
    if (cur_tid(F) == 0) {
        __builtin_amdgcn_fence(__ATOMIC_RELEASE, "agent");
        asm volatile("s_waitcnt vmcnt(0)" ::: "memory");
        __hip_atomic_fetch_add(cnt, 1u, __ATOMIC_RELAXED, __HIP_MEMORY_SCOPE_AGENT);
        unsigned spins = 0;
        while (__hip_atomic_load(cnt, __ATOMIC_RELAXED, __HIP_MEMORY_SCOPE_AGENT) < target) { __builtin_amdgcn_s_sleep(2); if (++spins > (1u << 22)) break; }
        __builtin_amdgcn_fence(__ATOMIC_ACQUIRE, "agent");
        asm volatile("s_waitcnt vmcnt(0)" ::: "memory");
    }
    __syncthreads();
}
__global__ void __launch_bounds__(NTHR, 2) fwd_kernel(Args args) {
    extern __shared__ __attribute__((aligned(16))) unsigned char lds[];
    cg::grid_group grid = cg::this_grid();
    Frame F;
    F.lds = (LAS unsigned char*)lds;
    F.wave = __builtin_amdgcn_readfirstlane((int)threadIdx.x >> 6);
    F.G = gridDim.x; { const int bx = blockIdx.x; F.vcu = (F.G % 8 == 0) ? (bx % 8) * (F.G / 8) + bx / 8 : bx; }
    F.xp = args.in[0]; F.xs = args.in[1]; F.ck = args.in[2]; F.cv = args.in[3]; F.st = args.in[4]; F.ng = args.in[5]; F.fg = args.in[6]; F.rb = args.in[7];
    F.wia = args.in[8]; F.sk = args.in[9]; F.woa = args.in[10]; F.wir = args.in[11]; F.wor = args.in[12];
    F.out = args.out; F.ws = args.ws;
    const int lo = args.ph_lo, hi = args.ph_hi;
#ifndef DUP_MASK
#define DUP_MASK 0
#endif
#define REP(k) for (int rep_ = 0; rep_ < 1 + ((DUP_MASK >> (k)) & 1) * DUP_N; ++rep_)
#ifndef DUP_N
#define DUP_N 1
#endif
#ifndef PH_MASK
#define PH_MASK 0x1ff
#endif
#define IN(k) (((PH_MASK >> (k)) & 1) && lo <= (k) && (k) < hi)
#define SEAM(k) do { if (IN(k) && IN((k) + 1)) { if ((k) == 0) grid.sync(); else grid_bar(F, bar_cnt, (unsigned)(k) * (unsigned)F.G); } } while (0)
    unsigned* bar_cnt = (unsigned*)(F.ws + 256);
    if (IN(0) && blockIdx.x == 0 && cur_tid(F) == 0) __hip_atomic_store(bar_cnt, 0u, __ATOMIC_RELAXED, __HIP_MEMORY_SCOPE_AGENT);

    if (IN(0)) REP(0) { p0_prologue(F); }
    SEAM(0);
    if (IN(1)) REP(1) {
        pg8::Gemm g{(const pg8::bf16_t*)(F.ws + WS_XN), (const pg8::bf16_t*)(F.ws + WS_WINA), MPR, ATT_IN, DM};
        pg8::StaticOrder S; S.init(MPR, ATT_IN, F.G, (int)blockIdx.x);
        EpiAttnIn E{(bf16*)(F.ws + WS_Q), (bf16*)(F.ws + WS_K), (bf16*)(F.ws + WS_V), (bf16*)(F.ws + WS_SG), F.out};
        pg8::gemm_phase<EpiAttnIn, pg8::StaticOrder, true, true>(F.lds, g, S, E, F.wave);
        p1_sample(F);
    }
    SEAM(1);
    if (IN(2)) REP(2) { p2_attention(F); }
    SEAM(2);
    if (IN(3)) REP(3) {
        pg8::Gemm g{(const pg8::bf16_t*)(F.ws + WS_OG), (const pg8::bf16_t*)(F.ws + WS_WOA), MPR, DM, AW};
        pg8::StaticOrder S; S.init(MPR, DM, F.G, (int)blockIdx.x);
        EpiOutRes E{F.xp, F.xs, (bf16*)(F.ws + WS_XN), (float*)(F.ws + WS_SSQ1)};
        pg8::gemm_phase<EpiOutRes, pg8::StaticOrder, true, true>(F.lds, g, S, E, F.wave);
        p3_sample(F);
    }
    SEAM(3);
    if (IN(4)) REP(4) {
        pg8::Gemm g{(const pg8::bf16_t*)(F.ws + WS_XN), (const pg8::bf16_t*)(F.ws + WS_WINR), MPR, RET_IN, DM};
        pg8::StaticOrder S; S.init(MPR, RET_IN, F.G, (int)blockIdx.x);
        EpiRetIn E{(const float*)(F.ws + WS_SSQ1), (const float*)(F.ws + WS_COS), (const float*)(F.ws + WS_SIN), (bf16*)(F.ws + WS_Q), (bf16*)(F.ws + WS_Q) + (size_t)MPAD * DM, (bf16*)(F.ws + WS_SG), (bf16*)(F.ws + WS_OG)};
        pg8::gemm_phase<EpiRetIn, pg8::StaticOrder, true, true>(F.lds, g, S, E, F.wave);
        p4_sample(F);
    }
    SEAM(4);
    if (IN(5)) REP(5) { p5_retention(F); }
    SEAM(5);
    if (IN(6)) REP(6) { p5b_normalize(F); }
    SEAM(6);
    if (IN(7)) REP(7) {
        pg8::Gemm g{(const pg8::bf16_t*)(F.ws + WS_ORAW), (const pg8::bf16_t*)(F.ws + WS_WOR), MPR, DM, AW};
        pg8::StaticOrder S; S.init(MPR, DM, F.G, (int)blockIdx.x);
        EpiOutFinal E{(const bf16*)(F.ws + WS_XN), F.out};
        pg8::gemm_phase<EpiOutFinal, pg8::StaticOrder, true, true>(F.lds, g, S, E, F.wave);
        p6_sample(F);
    }
    SEAM(7);
    if (IN(8)) REP(8) { p7_final_norm(F); }
#undef IN
#undef SEAM
}

extern "C" void kernel_launch(void* const* d_in, const int* in_sizes, int n_in, void* d_out, int out_size, void* d_ws, size_t ws_size, hipStream_t stream) {
    static int grid = 0;
    if (grid == 0) {
        if (n_in != 13 || (size_t)out_size != O_END || ws_size < WS_END) { fprintf(stderr, "kernel_launch: unexpected shapes: n_in %d out %d ws %zu\n", n_in, out_size, ws_size); grid = -1; return; }
        int dev = 0, cus = 0, per_cu = 0;
        (void)hipGetDevice(&dev); (void)hipDeviceGetAttribute(&cus, hipDeviceAttributeMultiprocessorCount, dev);
        (void)hipFuncSetAttribute((const void*)fwd_kernel, hipFuncAttributeMaxDynamicSharedMemorySize, LDS_BYTES);
        (void)hipOccupancyMaxActiveBlocksPerMultiprocessor(&per_cu, (const void*)fwd_kernel, NTHR, LDS_BYTES);
        if (per_cu < 1) { fprintf(stderr, "kernel_launch: occupancy query says %d blocks per CU\n", per_cu); per_cu = 1; }
        (void)hipGetLastError();
        grid = cus;
        fprintf(stderr, "kernel_launch: cus %d per_cu %d grid %d\n", cus, per_cu, grid);
    }
    if (grid < 0) return;
    Args a{};
    for (int i = 0; i < 13; ++i) a.in[i] = (const float*)d_in[i];
    a.out = (float*)d_out; a.ws = (unsigned char*)d_ws; a.ph_lo = 0; a.ph_hi = 9;
    void* kargs[] = {&a};
    hipError_t e = hipLaunchCooperativeKernel((const void*)fwd_kernel, dim3(grid), dim3(NTHR), kargs, LDS_BYTES, stream);
    if (e != hipSuccess) fprintf(stderr, "kernel_launch: cooperative launch failed: %s (grid %d)\n", hipGetErrorString(e), grid);
}
```

```cpp
#include <hip/hip_runtime.h>
#include <hip/hip_cooperative_groups.h>
#include <hip/hip_bf16.h>
#include <cstdio>
#include <cstdint>
#include <cmath>
namespace cg = cooperative_groups;

namespace pg8 {
#define PG8_LAS __attribute__((address_space(3)))
typedef unsigned short bf16_t;
typedef short bf16x8 __attribute__((ext_vector_type(8)));
typedef float f32x4 __attribute__((ext_vector_type(4)));
typedef unsigned u32x4 __attribute__((ext_vector_type(4)));
constexpr int BM = 256, BK = 64, HALF = 128, HTB = HALF * BK * 2  , STAGE_BYTES = 8 * HTB, NXCD = 8, WGM = 8;

__host__ __device__ __forceinline__ int lds_byte(int r, int c) { const int st = (r >> 4) * 2 + (c >> 5), rr = r & 15, cc = c & 31, ob = rr * 64 + cc * 2; return st * 1024 + (ob ^ (((ob >> 9) & 1) << 5)); }
__host__ __device__ __forceinline__ void stage_rc(int b, int& R, int& C) { const int st = b / 1024, sb = b % 1024, swz = sb ^ (((sb >> 9) & 1) << 5); R = (st >> 1) * 16 + swz / 64; C = (st & 1) * 32 + (swz % 64) / 2; }
__host__ __device__ __forceinline__ int perm32(int rho) { const int n = rho >> 4, i = rho & 15; return 8 * (i >> 2) + 4 * n + (i & 3); }

struct Unit { int pm, pn; };
struct Gemm { const bf16_t* A; const bf16_t* Bt; int M, N, K; };

struct StaticOrder {
    int nM, nN, nwg, G, c;
    __host__ __device__ void init(int M, int N, int G_, int c_) { nM = M / BM; nN = N / BM; nwg = nM * nN; G = G_; c = c_; }
    __host__ __device__ bool next(int i, Unit& u) const {
        const long L = (long)i * G + c; if (L >= nwg) return false;
        int wgid = (int)L; { const int q = nwg / NXCD, r = nwg % NXCD, xcd = wgid % NXCD, off = wgid / NXCD; wgid = (xcd < r ? xcd * (q + 1) : r * (q + 1) + (xcd - r) * q) + off; }
        const int nig = WGM * nN, gid = wgid / nig, fm = gid * WGM, gsz = (nM - fm) < WGM ? (nM - fm) : WGM;
        u.pm = fm + ((wgid % nig) % gsz); u.pn = (wgid % nig) / gsz; return true;
    }
    __device__ __forceinline__ void a_ready(const Unit&) const {}
    __device__ __forceinline__ void done(const Unit&) const {}
};

__device__ __forceinline__ unsigned cvt_pk_bf16(float lo, float hi) { unsigned r; asm volatile("v_cvt_pk_bf16_f32 %0, %1, %2" : "=v"(r) : "v"(lo), "v"(hi)); return r; }
typedef float f32x2 __attribute__((ext_vector_type(2)));
__device__ __forceinline__ f32x2 gelu_pk(f32x2 v) {
    const f32x2 av = __builtin_elementwise_abs(v), d = av * 0.2316418882f + 1.0f;
    f32x2 t; t.x = __builtin_amdgcn_rcpf(d.x); t.y = __builtin_amdgcn_rcpf(d.y);
    f32x2 q = t * 0.5307027145f + (-0.7265760135f); q = q * t + 0.7107068705f; q = q * t + (-0.142248368f); q = q * t + 0.127414796f; q = q * t;
    const f32x2 s = (v * v) * (-0.72134752044f);
    f32x2 e; e.x = __builtin_amdgcn_exp2f(s.x); e.y = __builtin_amdgcn_exp2f(s.y);
    const f32x2 m = v * (q * e), r = v - m;
    f32x2 o; o.x = v.x < 0.f ? m.x : r.x; o.y = v.y < 0.f ? m.y : r.y; return o;
}

template <int ACT  > struct EpiBf16 {
    static constexpr bool PERM = true, AFTER_DRAIN = false; static_assert(ACT == 0 || ACT == 1, "EpiBf16: ACT is 0 (none) or 1 (gelu_pk)");
    bf16_t* O; int ldc; const float* bias; int split_cols; size_t split_stride; float scale0;
    __device__ __forceinline__ void operator()(const f32x4 (&acc)[2][2][4][2], const Unit& u, int wr, int wc, int fr, int fq) const {
        const int row0 = u.pm * BM + wr * 64 + fr; int colt = u.pn * BM; bf16_t* base = O;
        float sc = 1.f; if (split_cols) { const int t = colt / split_cols; base += (size_t)t * split_stride; colt -= t * split_cols; if (t == 0) sc = scale0; }
        const int col0 = colt + wc * 32 + 8 * fq, bcol0 = u.pn * BM + wc * 32 + 8 * fq;
        f32x4 bv[2][2];
#pragma unroll
        for (int bj = 0; bj < 2; ++bj)
#pragma unroll
            for (int n = 0; n < 2; ++n) bv[bj][n] = bias ? *(const f32x4*)(bias + bcol0 + bj * HALF + 4 * n) : (f32x4){0.f, 0.f, 0.f, 0.f};
#pragma unroll
        for (int ai = 0; ai < 2; ++ai)
#pragma unroll
            for (int m = 0; m < 4; ++m) { bf16_t* rowp = base + (size_t)(row0 + ai * HALF + m * 16) * ldc + col0;
#pragma unroll
                for (int bj = 0; bj < 2; ++bj) { f32x4 v0 = acc[ai][bj][m][0] + bv[bj][0], v1 = acc[ai][bj][m][1] + bv[bj][1];
                    if (ACT == 1) { f32x2 a = gelu_pk((f32x2){v0[0], v0[1]}), b = gelu_pk((f32x2){v0[2], v0[3]}), c = gelu_pk((f32x2){v1[0], v1[1]}), d = gelu_pk((f32x2){v1[2], v1[3]});
                        v0 = (f32x4){a.x, a.y, b.x, b.y}; v1 = (f32x4){c.x, c.y, d.x, d.y}; }
                    v0 = v0 * sc; v1 = v1 * sc; u32x4 w; w.x = cvt_pk_bf16(v0[0], v0[1]); w.y = cvt_pk_bf16(v0[2], v0[3]); w.z = cvt_pk_bf16(v1[0], v1[1]); w.w = cvt_pk_bf16(v1[2], v1[3]);
                    *(u32x4*)(rowp + bj * HALF) = w; } }
    }
};


template <class Epi, class Sched, bool ALIGN_EPI = false, bool SP2 = false>
__device__ __forceinline__ void gemm_phase(PG8_LAS unsigned char* lds, const Gemm g, const Sched& S, const Epi& E, const int wid) {
    int lane_; asm volatile("v_mbcnt_lo_u32_b32 %0, -1, 0\n\tv_mbcnt_hi_u32_b32 %0, -1, %0" : "=v"(lane_)); const int lane = lane_, tid = wid * 64 + lane, wr = wid >> 2, wc = wid & 3, fr = lane & 15, fq = lane >> 4;
    const int K = g.K, nt = K / BK;
    unsigned voffA[2], voffB[2];
#pragma unroll
    for (int i = 0; i < 2; ++i) { int R, C; stage_rc(tid * 16 + i * 8192, R, C); const int Rb = Epi::PERM ? ((R & ~31) + perm32(R & 31)) : R;
        voffA[i] = (unsigned)(R * K + C) * 2u; voffB[i] = (unsigned)(Rb * K + C) * 2u; }
    const size_t kstep = (size_t)(BK * 2);
    const size_t hstep = (size_t)HALF * K * 2;
    const size_t tstep = 2 * hstep;
    const unsigned ldsw = (unsigned)wid * 1024u;
    const int aoff = lds_byte(wr * 64 + fr, fq * 8), boff = lds_byte(wc * 32 + fr, fq * 8);
#define PG8_SA(b, h) (((b) * 2 + (h)) * HTB)
#define PG8_SB(b, h) ((4 + (b) * 2 + (h)) * HTB)
#define PG8_STAGE(bufoff, gbase, voff) do { _Pragma("unroll") for (int _i = 0; _i < 2; ++_i) \
        __builtin_amdgcn_global_load_lds((const unsigned*)((const char*)(gbase) + (voff)[_i]), (PG8_LAS unsigned*)(lds + (bufoff) + ldsw + _i * 8192), 16, 0, 0); } while (0)
#define PG8_LDA(dst, b, h) do { _Pragma("unroll") for (int m = 0; m < 4; ++m) _Pragma("unroll") for (int k = 0; k < 2; ++k) dst[m][k] = *(const PG8_LAS bf16x8*)(lds + PG8_SA(b, h) + aoff + m * 2048 + k * 1024); } while (0)
#define PG8_LDB(dst, b, h) do { _Pragma("unroll") for (int n = 0; n < 2; ++n) _Pragma("unroll") for (int k = 0; k < 2; ++k) dst[n][k] = *(const PG8_LAS bf16x8*)(lds + PG8_SB(b, h) + boff + n * 2048 + k * 1024); } while (0)
#define PG8_MMA(ai, bj, At, Bt) do { __builtin_amdgcn_s_setprio(1); _Pragma("unroll") for (int m = 0; m < 4; ++m) _Pragma("unroll") for (int n = 0; n < 2; ++n) _Pragma("unroll") for (int k = 0; k < 2; ++k) \
        acc[ai][bj][m][n] = __builtin_amdgcn_mfma_f32_16x16x32_bf16(Bt[n][k], At[m][k], acc[ai][bj][m][n], 0, 0, 0); __builtin_amdgcn_s_setprio(0); } while (0)
#define PG8_WAIT_V(n) asm volatile("s_waitcnt vmcnt(" #n ")" ::: "memory")
#define PG8_WAIT_L(n) asm volatile("s_waitcnt lgkmcnt(" #n ")" ::: "memory")
#define PG8_BAR __builtin_amdgcn_s_barrier()
#define PG8_SCHED __builtin_amdgcn_sched_barrier(0)
    Unit cur, nxt; int ui = 0;
    if (!S.next(0, cur)) return;
    f32x4 acc[2][2][4][2];
#pragma unroll
    for (int a = 0; a < 2; ++a)
#pragma unroll
        for (int b = 0; b < 2; ++b)
#pragma unroll
            for (int m = 0; m < 4; ++m)
#pragma unroll
                for (int n = 0; n < 2; ++n) acc[a][b][m][n] = (f32x4){0.f, 0.f, 0.f, 0.f};
    bf16x8 At[4][2], B0[2][2], B1[2][2];
    const char* cA = (const char*)g.A + (size_t)cur.pm * tstep; const char* cB = (const char*)g.Bt + (size_t)cur.pn * tstep;
    S.a_ready(cur);
    if constexpr (SP2) {
        PG8_STAGE(PG8_SB(0, 0), cB, voffB); PG8_STAGE(PG8_SB(0, 1), cB + hstep, voffB); PG8_STAGE(PG8_SA(0, 0), cA, voffA); PG8_STAGE(PG8_SA(0, 1), cA + hstep, voffA);
        if (wr == 1) PG8_BAR;
        PG8_WAIT_V(2); PG8_BAR;
        PG8_STAGE(PG8_SB(1, 0), cB + kstep, voffB); PG8_STAGE(PG8_SA(1, 0), cA + kstep, voffA); PG8_STAGE(PG8_SB(1, 1), cB + hstep + kstep, voffB);
        PG8_WAIT_V(6); PG8_BAR;
    } else {
        PG8_STAGE(PG8_SB(0, 0), cB, voffB); PG8_STAGE(PG8_SA(0, 0), cA, voffA); PG8_STAGE(PG8_SB(0, 1), cB + hstep, voffB); PG8_STAGE(PG8_SA(0, 1), cA + hstep, voffA);
        if (wr == 1) PG8_BAR;
        PG8_WAIT_V(4); PG8_BAR;
        PG8_STAGE(PG8_SB(1, 0), cB + kstep, voffB); PG8_STAGE(PG8_SA(1, 0), cA + kstep, voffA); PG8_STAGE(PG8_SB(1, 1), cB + hstep + kstep, voffB);
        PG8_WAIT_V(6); PG8_BAR;
    }
    for (;;) {
        const bool has_next = S.next(ui + 1, nxt);
        const char* nA = has_next ? (const char*)g.A + (size_t)nxt.pm * tstep : cA; const char* nB = has_next ? (const char*)g.Bt + (size_t)nxt.pn * tstep : cB;
        for (int t = 0; t < nt; t += 2) {
            const bool last = (t == nt - 2);
            const char* a1 = cA + (size_t)(t + 1) * kstep;
            const char* a2 = last ? nA : cA + (size_t)(t + 2) * kstep; const char* b2 = last ? nB : cB + (size_t)(t + 2) * kstep;
            const char* a3 = a2 + kstep; const char* b3 = b2 + kstep;
            if (last && has_next) S.a_ready(nxt);
            if constexpr (SP2) {
            PG8_LDB(B0, 0, 0); PG8_LDB(B1, 0, 1); PG8_SCHED; PG8_LDA(At, 0, 0); PG8_STAGE(PG8_SA(1, 1), a1 + hstep, voffA);
            PG8_WAIT_V(8); PG8_WAIT_L(0); PG8_BAR; PG8_MMA(0, 0, At, B0); PG8_MMA(0, 1, At, B1); PG8_BAR; PG8_SCHED;
            PG8_LDA(At, 0, 1); PG8_STAGE(PG8_SB(0, 0), b2, voffB); PG8_STAGE(PG8_SB(0, 1), b2 + hstep, voffB); PG8_STAGE(PG8_SA(0, 0), a2, voffA);
            PG8_WAIT_V(8); PG8_WAIT_L(0); PG8_BAR; PG8_MMA(1, 0, At, B0); PG8_MMA(1, 1, At, B1); PG8_BAR; PG8_SCHED;
            PG8_LDB(B0, 1, 0); PG8_LDB(B1, 1, 1); PG8_SCHED; PG8_LDA(At, 1, 0); PG8_STAGE(PG8_SA(0, 1), a2 + hstep, voffA);
            PG8_WAIT_V(8); PG8_WAIT_L(0); PG8_BAR; PG8_MMA(0, 0, At, B0); PG8_MMA(0, 1, At, B1); PG8_BAR; PG8_SCHED;
            PG8_LDA(At, 1, 1); PG8_STAGE(PG8_SB(1, 0), b3, voffB); PG8_STAGE(PG8_SB(1, 1), b3 + hstep, voffB); PG8_STAGE(PG8_SA(1, 0), a3, voffA);
            PG8_WAIT_V(8); PG8_WAIT_L(0); PG8_BAR; PG8_MMA(1, 0, At, B0); PG8_MMA(1, 1, At, B1); PG8_BAR; PG8_SCHED;
            } else {
            PG8_LDB(B0, 0, 0); PG8_SCHED; PG8_LDA(At, 0, 0); PG8_STAGE(PG8_SA(1, 1), a1 + hstep, voffA);
            PG8_WAIT_L(8); PG8_BAR; PG8_WAIT_L(0); PG8_MMA(0, 0, At, B0); PG8_BAR; PG8_SCHED;
            PG8_LDB(B1, 0, 1); PG8_STAGE(PG8_SB(0, 0), b2, voffB);
            PG8_BAR; PG8_WAIT_L(0); PG8_MMA(0, 1, At, B1); PG8_BAR;
            PG8_LDA(At, 0, 1); PG8_STAGE(PG8_SA(0, 0), a2, voffA);
            PG8_BAR; PG8_WAIT_L(0); PG8_MMA(1, 0, At, B0); PG8_BAR; PG8_SCHED;
            PG8_STAGE(PG8_SB(0, 1), b2 + hstep, voffB);
            PG8_WAIT_V(6); PG8_BAR; PG8_MMA(1, 1, At, B1); PG8_BAR;
            PG8_LDB(B0, 1, 0); PG8_SCHED; PG8_LDA(At, 1, 0); PG8_STAGE(PG8_SA(0, 1), a2 + hstep, voffA);
            PG8_WAIT_L(8); PG8_BAR; PG8_WAIT_L(0); PG8_MMA(0, 0, At, B0); PG8_BAR; PG8_SCHED;
            PG8_LDB(B1, 1, 1); PG8_STAGE(PG8_SB(1, 0), b3, voffB);
            PG8_BAR; PG8_WAIT_L(0); PG8_MMA(0, 1, At, B1); PG8_BAR;
            PG8_LDA(At, 1, 1); PG8_STAGE(PG8_SA(1, 0), a3, voffA);
            PG8_BAR; PG8_WAIT_L(0); PG8_MMA(1, 0, At, B0); PG8_BAR; PG8_SCHED;
            PG8_STAGE(PG8_SB(1, 1), b3 + hstep, voffB);
            PG8_WAIT_V(6); PG8_BAR; PG8_MMA(1, 1, At, B1); PG8_BAR;
            }
        }
        if constexpr (ALIGN_EPI) { if (wr == 0) PG8_BAR; }
        if constexpr (!Epi::AFTER_DRAIN) { E(acc, cur, wr, wc, fr, fq); S.done(cur); }
        if (!has_next) break;
#pragma unroll
        for (int a = 0; a < 2; ++a)
#pragma unroll
            for (int b = 0; b < 2; ++b)
#pragma unroll
                for (int m = 0; m < 4; ++m)
#pragma unroll
                    for (int n = 0; n < 2; ++n) acc[a][b][m][n] = (f32x4){0.f, 0.f, 0.f, 0.f};
        cur = nxt; cA = nA; cB = nB; ++ui;
        if constexpr (ALIGN_EPI) { if (wr == 1) PG8_BAR; }
    }
    PG8_WAIT_V(0);
    if constexpr (!ALIGN_EPI) { if (wr == 0) PG8_BAR; }
    PG8_BAR;
    if constexpr (Epi::AFTER_DRAIN) { E.fused(acc, cur, wr, wc, fr, fq, lds, wid, lane); S.done(cur); }
#undef PG8_SA
#undef PG8_SB
#undef PG8_STAGE
#undef PG8_LDA
#undef PG8_LDB
#undef PG8_MMA
#undef PG8_WAIT_V
#undef PG8_WAIT_L
#undef PG8_BAR
#undef PG8_SCHED
}
}

constexpr int DM = 1024, NB = 16, SEQ = 2048, MPR = NB * SEQ  , NS = 128  , MV = MPR + NS  , MPAD = 33024  ;
constexpr int ATT_IN = 4608, RET_IN = 6144, AW = 2048  , KVW = 256;
constexpr int PAST = 16384;
constexpr float EPS = 1e-6f;
constexpr float LOG2E = 1.4426950408889634f;
constexpr float C2 = 0.125f * LOG2E;
constexpr int NWAVES = 8, NTHR = 512;

constexpr size_t O_YP = 0, O_YS = 33554432, O_KP = 33685504, O_VP = 34209792, O_RP = 34734080, O_KS = 43122688, O_VS = 47316992, O_RS = 51511296, O_END = 118620160;

constexpr size_t MiB = 1u << 20;
constexpr size_t WS_WINA = 1 * MiB;
constexpr size_t WS_WOA  = 11 * MiB;
constexpr size_t WS_WINR = 16 * MiB;
constexpr size_t WS_WOR  = 29 * MiB;
constexpr size_t WS_COS  = 34 * MiB;
constexpr size_t WS_SIN  = 36 * MiB;
constexpr size_t WS_BT   = 38 * MiB;
constexpr size_t WS_SSQ1 = 39 * MiB;
constexpr size_t WS_STAT = 42 * MiB;
constexpr size_t WS_XN   = 60 * MiB;
constexpr size_t WS_Q    = 126 * MiB;
constexpr size_t WS_K    = 256 * MiB;
constexpr size_t WS_V    = 273 * MiB;
constexpr size_t WS_SG   = 290 * MiB;
constexpr size_t WS_OG   = 420 * MiB;
constexpr size_t WS_X1   = 550 * MiB;
constexpr size_t WS_ORAW = 680 * MiB;
constexpr size_t WS_END  = 810 * MiB;
static_assert(WS_WINA + (size_t)ATT_IN * DM * 2 <= WS_WOA && WS_WOA + (size_t)DM * AW * 2 <= WS_WINR && WS_WINR + (size_t)RET_IN * DM * 2 <= WS_WOR && WS_WOR + (size_t)DM * AW * 2 <= WS_COS, "ws map weights");
static_assert(WS_COS + 2049 * 128 * 4 <= WS_SIN && WS_SIN + 2049 * 128 * 4 <= WS_BT && WS_SSQ1 + (size_t)MPAD * 16 * 4 <= WS_STAT && WS_STAT + (size_t)MPAD * 4 * 16 * 2 * 4 <= WS_XN, "ws map tables");
static_assert(WS_XN + (size_t)MPAD * DM * 2 <= WS_Q && WS_Q + (size_t)MPAD * AW * 2 <= WS_K && WS_K + (size_t)MPAD * KVW * 2 <= WS_V && WS_V + (size_t)MPAD * KVW * 2 <= WS_SG, "ws map act 1");
static_assert(WS_SG + (size_t)MPAD * AW * 2 <= WS_OG && WS_OG + (size_t)MPAD * AW * 2 <= WS_X1 && WS_X1 + (size_t)MPAD * DM * 4 <= WS_ORAW && WS_ORAW + (size_t)MPAD * AW * 2 <= WS_END, "ws map act 2");

constexpr int LDS_BYTES = 147456;

#define GAS __attribute__((address_space(1)))
#define LAS __attribute__((address_space(3)))
typedef unsigned short bf16;
typedef unsigned v4u __attribute__((ext_vector_type(4)));
typedef unsigned v2u __attribute__((ext_vector_type(2)));
typedef float f32x4 __attribute__((ext_vector_type(4)));
typedef float f32x16 __attribute__((ext_vector_type(16)));
typedef short bf16x8 __attribute__((ext_vector_type(8)));
typedef short s16x4 __attribute__((ext_vector_type(4)));
#define LDS_WAIT() asm volatile("s_waitcnt lgkmcnt(0)" ::: "memory")
#define VM_WAIT() asm volatile("s_waitcnt vmcnt(0)" ::: "memory")

__device__ __forceinline__ unsigned f2bf(float f) { unsigned u = __builtin_bit_cast(unsigned, f); return (u + 0x7fffu + ((u >> 16) & 1u)) >> 16; }
typedef float f32x2_t __attribute__((ext_vector_type(2))); typedef __bf16 bf16x2_t __attribute__((ext_vector_type(2)));
__device__ __forceinline__ unsigned cvtpk(float lo, float hi) { f32x2_t v = {lo, hi}; bf16x2_t b = __builtin_convertvector(v, bf16x2_t); return __builtin_bit_cast(unsigned, b); }
__device__ __forceinline__ unsigned pk2(float lo, float hi) { return cvtpk(lo, hi); }
__device__ __forceinline__ float bf2f(unsigned short b) { return __builtin_bit_cast(float, (unsigned)b << 16); }
__device__ __forceinline__ float bflo(unsigned w) { return __builtin_bit_cast(float, w << 16); }
__device__ __forceinline__ float bfhi(unsigned w) { return __builtin_bit_cast(float, w & 0xffff0000u); }
__device__ __forceinline__ float silu_f(float x) { return x * __builtin_amdgcn_rcpf(1.0f + __expf(-x)); }
__device__ __forceinline__ float wave_sum(float v) {
#pragma unroll
    for (int o = 1; o < 64; o <<= 1) v += __shfl_xor(v, o);
    return v;
}
__device__ __forceinline__ float wave_max(float v) {
#pragma unroll
    for (int o = 1; o < 64; o <<= 1) v = fmaxf(v, __shfl_xor(v, o));
    return v;
}

struct Args { const float* in[13]; float* out; unsigned char* ws; int ph_lo, ph_hi; };

struct Frame {
    LAS unsigned char* lds;
    int wave, vcu, G;
    const float *xp, *xs, *ck, *cv, *st, *ng, *fg, *rb, *wia, *sk, *woa, *wir, *wor;
    float* out; unsigned char* ws;
};

__device__ __forceinline__ int lane_id() { int l; asm volatile("v_mbcnt_lo_u32_b32 %0, -1, 0\n\tv_mbcnt_hi_u32_b32 %0, -1, %0" : "=v"(l)); return l; }
__device__ __forceinline__ int cur_tid(const Frame& F) { return F.wave * 64 + lane_id(); }
__device__ __forceinline__ void p0_transpose_item(const float* W, int K, int N, bf16* WT, LAS float* scr, int item, int lane, const float* gk = nullptr) {
    const int nblk = N / 32, kb = item / nblk, nb = item % nblk, k0 = 64 * kb, n0 = 32 * nb;
#pragma unroll 16
    for (int i = 0; i < 32; ++i) { const int kk = 2 * i + (lane >> 5); const float gv = gk ? gk[k0 + kk] : 1.0f; scr[kk * 33 + (lane & 31)] = W[(size_t)(k0 + kk) * N + n0 + (lane & 31)] * gv; }
    LDS_WAIT(); asm volatile("" ::: "memory");
    const int c = lane & 7;
#pragma unroll
    for (int j = 0; j < 4; ++j) { const int n = (lane >> 3) + 8 * j; const LAS float* s = scr + (8 * c) * 33 + n;
        v4u o; o.x = pk2(s[0 * 33], s[1 * 33]); o.y = pk2(s[2 * 33], s[3 * 33]); o.z = pk2(s[4 * 33], s[5 * 33]); o.w = pk2(s[6 * 33], s[7 * 33]);
        *(GAS v4u*)(WT + (size_t)(n0 + n) * K + k0 + 8 * c) = o; }
    LDS_WAIT(); asm volatile("" ::: "memory");
}
__device__ __forceinline__ void rms_row_to_bf16(int lane, const float* xrow, const float* g, bf16* orow) {
    const GAS f32x4* xr = (const GAS f32x4*)xrow + lane; const GAS f32x4* gr = (const GAS f32x4*)g + lane;
    f32x4 v[4]; float s = 0.f;
#pragma unroll
    for (int j = 0; j < 4; ++j) { v[j] = xr[64 * j]; s += (v[j].x * v[j].x + v[j].y * v[j].y) + (v[j].z * v[j].z + v[j].w * v[j].w); }
    const float rstd = 1.0f / sqrtf(wave_sum(s) * (1.f / DM) + EPS);
    GAS unsigned long long* o8 = (GAS unsigned long long*)orow + lane;
#pragma unroll
    for (int j = 0; j < 4; ++j) { const f32x4 gg = gr[64 * j];
        o8[64 * j] = (unsigned long long)pk2(v[j].x * rstd * gg.x, v[j].y * rstd * gg.y) | ((unsigned long long)pk2(v[j].z * rstd * gg.z, v[j].w * rstd * gg.w) << 32); }
}
__device__ __forceinline__ int t5_bucket(int n) {
    if (n < 16) return n;
    int l = 16 + (int)(logf((float)n / 16.0f) / logf(8.0f) * 16.0f);
    return l < 31 ? l : 31;
}
__device__ __forceinline__ void p0_prologue(Frame& F) {
    LAS float* scr = (LAS float*)(F.lds + F.wave * 16384);
    const int gw = F.vcu * NWAVES + F.wave, NGW = F.G * NWAVES;
    bf16* WinA = (bf16*)(F.ws + WS_WINA); bf16* WoA = (bf16*)(F.ws + WS_WOA); bf16* WinR = (bf16*)(F.ws + WS_WINR); bf16* WoR = (bf16*)(F.ws + WS_WOR);
    constexpr int I_A = (DM / 64) * (ATT_IN / 32), I_B = (AW / 64) * (DM / 32), I_C = (DM / 64) * (RET_IN / 32), I_D = I_B;
    constexpr int NITEMS = I_A + I_B + I_C + I_D;
    for (int it = gw; it < NITEMS; it += NGW) {
        int r = it;
        if (r < I_A) { p0_transpose_item(F.wia, DM, ATT_IN, WinA, scr, r, lane_id()); continue; } r -= I_A;
        if (r < I_B) { p0_transpose_item(F.woa, AW, DM, WoA, scr, r, lane_id()); continue; } r -= I_B;
        if (r < I_C) { p0_transpose_item(F.wir, DM, RET_IN, WinR, scr, r, lane_id(), F.ng + DM); continue; } r -= I_C;
        p0_transpose_item(F.wor, AW, DM, WoR, scr, r, lane_id());
    }
    bf16* XN = (bf16*)(F.ws + WS_XN);
    {   const int lane = lane_id();
        for (int m = gw; m < MV; m += 2 * NGW) {
            const int m2 = m + NGW; const bool two = m2 < MV;
            const float* r0 = (m < MPR) ? F.xp + (size_t)m * DM : F.xs + (size_t)(m - MPR) * DM;
            const float* r1 = two ? ((m2 < MPR) ? F.xp + (size_t)m2 * DM : F.xs + (size_t)(m2 - MPR) * DM) : r0;
            const GAS f32x4* x0 = (const GAS f32x4*)r0 + lane; const GAS f32x4* x1 = (const GAS f32x4*)r1 + lane; const GAS f32x4* gr = (const GAS f32x4*)F.ng + lane;
            f32x4 a[4], b[4]; float sa = 0.f, sb = 0.f;
#pragma unroll
            for (int j = 0; j < 4; ++j) { a[j] = x0[64 * j]; b[j] = x1[64 * j]; }
#pragma unroll
            for (int j = 0; j < 4; ++j) { sa += (a[j].x * a[j].x + a[j].y * a[j].y) + (a[j].z * a[j].z + a[j].w * a[j].w); sb += (b[j].x * b[j].x + b[j].y * b[j].y) + (b[j].z * b[j].z + b[j].w * b[j].w); }
            const float ra = 1.0f / sqrtf(wave_sum(sa) * (1.f / DM) + EPS), rb = 1.0f / sqrtf(wave_sum(sb) * (1.f / DM) + EPS);
            GAS unsigned long long* o0 = (GAS unsigned long long*)(XN + (size_t)m * DM) + lane; GAS unsigned long long* o1 = (GAS unsigned long long*)(XN + (size_t)(two ? m2 : m) * DM) + lane;
#pragma unroll
            for (int j = 0; j < 4; ++j) { const f32x4 gg = gr[64 * j];
                o0[64 * j] = (unsigned long long)pk2(a[j].x * ra * gg.x, a[j].y * ra * gg.y) | ((unsigned long long)pk2(a[j].z * ra * gg.z, a[j].w * ra * gg.w) << 32);
                if (two) o1[64 * j] = (unsigned long long)pk2(b[j].x * rb * gg.x, b[j].y * rb * gg.y) | ((unsigned long long)pk2(b[j].z * rb * gg.z, b[j].w * rb * gg.w) << 32); }
        } }
    const int gt = F.vcu * NTHR + cur_tid(F), NGT = F.G * NTHR;
    float* COS = (float*)(F.ws + WS_COS); float* SIN = (float*)(F.ws + WS_SIN); float* BT = (float*)(F.ws + WS_BT);
    for (int i = gt; i < 2049 * 128; i += NGT) {
        const int p = i >> 7, f = i & 127; const double pos = (p == 2048) ? (double)PAST : (double)p;
        const double inv = exp(-(double)f * (9.210340371976184 / 128.0));
        const double ang = pos * inv;
        COS[i] = (float)cos(ang); SIN[i] = (float)sin(ang);
    }
    for (int i = gt; i < 32 * 128; i += NGT) { const int h = i >> 7, rel = i & 127; BT[i] = F.rb[t5_bucket(rel) * 32 + h] * LOG2E; }
    {   const GAS f32x4* ck = (const GAS f32x4*)F.ck; const GAS f32x4* cv = (const GAS f32x4*)F.cv;
        GAS f32x4* ok = (GAS f32x4*)(F.out + O_KS); GAS f32x4* ov = (GAS f32x4*)(F.out + O_VS);
        constexpr int NCP = NS * 127 * 64;
        for (int i0 = gt; i0 < NCP; i0 += 4 * NGT) { f32x4 kk[4], vv[4]; size_t dst[4];
#pragma unroll
            for (int j = 0; j < 4; ++j) { const int i = i0 + j * NGT, ic = i < NCP ? i : gt; const int s = ic / (127 * 64), r = ic - s * (127 * 64); dst[j] = (size_t)s * 8192 + r; kk[j] = ck[dst[j] + 64]; vv[j] = cv[dst[j] + 64]; }
#pragma unroll
            for (int j = 0; j < 4; ++j) if (i0 + j * NGT < NCP) { ok[dst[j]] = kk[j]; ov[dst[j]] = vv[j]; } } }
}

struct EpiAttnIn {
    static constexpr bool PERM = true, AFTER_DRAIN = false;
    bf16 *Q, *K, *V, *SG; float* out;
    __device__ __forceinline__ void operator()(const pg8::f32x4 (&acc)[2][2][4][2], const pg8::Unit& u, int wr, int wc, int fr, int fq) const {
        const int pn = u.pn, row0 = u.pm * 256 + wr * 64 + fr, cl0 = wc * 32 + 8 * fq;
#pragma unroll
        for (int ai = 0; ai < 2; ++ai)
#pragma unroll
            for (int m = 0; m < 4; ++m) { const int row = row0 + ai * 128 + m * 16;
#pragma unroll
                for (int bj = 0; bj < 2; ++bj) { const int cl = cl0 + bj * 128; pg8::f32x4 v0 = acc[ai][bj][m][0], v1 = acc[ai][bj][m][1];
                    if (pn < 8) { v0 = v0 * C2; v1 = v1 * C2; v4u w; w.x = pk2(v0[0], v0[1]); w.y = pk2(v0[2], v0[3]); w.z = pk2(v1[0], v1[1]); w.w = pk2(v1[2], v1[3]);
                        *(GAS v4u*)(Q + (size_t)row * AW + pn * 256 + cl) = w; }
                    else if (pn < 10) { v4u w; w.x = pk2(v0[0], v0[1]); w.y = pk2(v0[2], v0[3]); w.z = pk2(v1[0], v1[1]); w.w = pk2(v1[2], v1[3]);
                        bf16* dst = (pn == 8) ? K : V; *(GAS v4u*)(dst + (size_t)row * KVW + cl) = w;
                        float* o = nullptr;
                        if (row < MPR) { const int b = row >> 11, t = row & 2047; if (t >= SEQ - 128) o = out + (pn == 8 ? O_KP : O_VP) + (size_t)(b * 128 + t - (SEQ - 128)) * 256 + cl; }
                        else if (row < MV) { o = out + (pn == 8 ? O_KS : O_VS) + (size_t)((row - MPR) * 128 + 127) * 256 + cl; }
                        if (o) { *(GAS f32x4*)o = v0; *(GAS f32x4*)(o + 4) = v1; } }
                    else { v4u w; w.x = pk2(silu_f(v0[0]), silu_f(v0[1])); w.y = pk2(silu_f(v0[2]), silu_f(v0[3])); w.z = pk2(silu_f(v1[0]), silu_f(v1[1])); w.w = pk2(silu_f(v1[2]), silu_f(v1[3]));
                        *(GAS v4u*)(SG + (size_t)row * AW + (pn - 10) * 256 + cl) = w; } } }
    }
};

struct EpiOutRes {
    static constexpr bool PERM = false, AFTER_DRAIN = false;
    const float *xp, *xs; bf16* XN2; float* ssq;
    __device__ __forceinline__ void operator()(const pg8::f32x4 (&acc)[2][2][4][2], const pg8::Unit& u, int wr, int wc, int fr, int fq) const {
        const int row0 = u.pm * 256 + wr * 64 + fr, c0 = u.pn * 256 + wc * 32 + 4 * fq;
#pragma unroll
        for (int ai = 0; ai < 2; ++ai)
#pragma unroll
            for (int m = 0; m < 4; ++m) { const int row = row0 + ai * 128 + m * 16; const bool ok = row < MV;
                const float* xr = (row < MPR) ? xp + (size_t)row * DM : xs + (size_t)(ok ? row - MPR : 0) * DM;
                float sq = 0.f;
#pragma unroll
                for (int bj = 0; bj < 2; ++bj)
#pragma unroll
                    for (int n = 0; n < 2; ++n) { const int col = c0 + bj * 128 + n * 16;
                        if (ok) { const f32x4 x = *(const GAS f32x4*)(xr + col); const f32x4 v = x + acc[ai][bj][m][n];
                            v2u w; w.x = pk2(v[0], v[1]); w.y = pk2(v[2], v[3]); *(GAS v2u*)(XN2 + (size_t)row * DM + col) = w;
                            sq += (v[0] * v[0] + v[1] * v[1]) + (v[2] * v[2] + v[3] * v[3]); } }
                sq += __shfl_xor(sq, 16); sq += __shfl_xor(sq, 32);
                if (ok && fq == 0) ssq[(size_t)row * 16 + u.pn * 4 + wc] = sq; }
    }
};
struct EpiOutFinal {
    static constexpr bool PERM = false, AFTER_DRAIN = false;
    const bf16* X1b; float* out;
    __device__ __forceinline__ void operator()(const pg8::f32x4 (&acc)[2][2][4][2], const pg8::Unit& u, int wr, int wc, int fr, int fq) const {
        const int row0 = u.pm * 256 + wr * 64 + fr, c0 = u.pn * 256 + wc * 32 + 4 * fq;
#pragma unroll
        for (int ai = 0; ai < 2; ++ai)
#pragma unroll
            for (int m = 0; m < 4; ++m) { const int row = row0 + ai * 128 + m * 16;
                if (row < MV) { float* orow = (row < MPR) ? out + O_YP + (size_t)row * DM : out + O_YS + (size_t)(row - MPR) * DM;
#pragma unroll
                    for (int bj = 0; bj < 2; ++bj)
#pragma unroll
                        for (int n = 0; n < 2; ++n) { const int col = c0 + bj * 128 + n * 16;
                            const v2u xw = *(const GAS v2u*)(X1b + (size_t)row * DM + col); const f32x4 x = {bflo(xw.x), bfhi(xw.x), bflo(xw.y), bfhi(xw.y)}; *(GAS f32x4*)(orow + col) = x + acc[ai][bj][m][n]; } } }
    }
};
struct EpiRetIn {
    static constexpr bool PERM = true, AFTER_DRAIN = false;
    const float *ssq, *COS, *SIN; bf16 *Qr, *Kr, *Vr, *SG2;
    __device__ __forceinline__ void operator()(const pg8::f32x4 (&acc)[2][2][4][2], const pg8::Unit& u, int wr, int wc, int fr, int fq) const {
        const int pn = u.pn, row0 = u.pm * 256 + wr * 64 + fr, cl0 = wc * 32 + 8 * fq;
#pragma unroll
        for (int ai = 0; ai < 2; ++ai)
#pragma unroll
            for (int m = 0; m < 4; ++m) { const int row = row0 + ai * 128 + m * 16;
                float rstd = 0.f;
                if (row < MV) { const GAS f32x4* sp = (const GAS f32x4*)(ssq + (size_t)row * 16); const f32x4 a = sp[0], b = sp[1], c = sp[2], d = sp[3];
                    const float s = ((a[0] + a[1]) + (a[2] + a[3])) + ((b[0] + b[1]) + (b[2] + b[3])) + ((c[0] + c[1]) + (c[2] + c[3])) + ((d[0] + d[1]) + (d[2] + d[3]));
                    rstd = 1.0f / sqrtf(s * (1.f / DM) + EPS); }
                if (pn < 8) {
                    const int p = (row < MPR) ? (row & 2047) : 2048;
                    const float lg = __builtin_amdgcn_logf(1.0f - __builtin_amdgcn_exp2f(-5.0f - (float)(pn & 3))) * (float)(row & 63);
                    const float sc = (pn < 4) ? rstd * __builtin_amdgcn_exp2f(lg) : rstd * 0.0625f * __builtin_amdgcn_exp2f(-lg);
                    bf16* dst = ((pn < 4) ? Qr : Kr) + (size_t)row * DM + (pn & 3) * 256 + cl0;
                    const GAS f32x4* cp = (const GAS f32x4*)(COS + p * 128 + cl0); const GAS f32x4* sp = (const GAS f32x4*)(SIN + p * 128 + cl0);
                    v4u w1, w2;
#pragma unroll
                    for (int n = 0; n < 2; ++n) { const f32x4 cc = cp[n], ss = sp[n]; const f32x4 x1 = acc[ai][0][m][n] * sc, x2 = acc[ai][1][m][n] * sc;
                        const f32x4 o1 = x1 * cc - x2 * ss, o2 = x1 * ss + x2 * cc;
                        if (n == 0) { w1.x = pk2(o1[0], o1[1]); w1.y = pk2(o1[2], o1[3]); w2.x = pk2(o2[0], o2[1]); w2.y = pk2(o2[2], o2[3]); }
                        else { w1.z = pk2(o1[0], o1[1]); w1.w = pk2(o1[2], o1[3]); w2.z = pk2(o2[0], o2[1]); w2.w = pk2(o2[2], o2[3]); } }
                    *(GAS v4u*)dst = w1; *(GAS v4u*)(dst + 128) = w2;
                } else {
#pragma unroll
                    for (int bj = 0; bj < 2; ++bj) { const int cl = cl0 + bj * 128; const pg8::f32x4 v0 = acc[ai][bj][m][0] * rstd, v1 = acc[ai][bj][m][1] * rstd; v4u w;
                        if (pn < 16) { w.x = pk2(v0[0], v0[1]); w.y = pk2(v0[2], v0[3]); w.z = pk2(v1[0], v1[1]); w.w = pk2(v1[2], v1[3]);
                            *(GAS v4u*)(Vr + (size_t)row * AW + (pn - 8) * 256 + cl) = w; }
                        else { w.x = pk2(silu_f(v0[0]), silu_f(v0[1])); w.y = pk2(silu_f(v0[2]), silu_f(v0[3])); w.z = pk2(silu_f(v1[0]), silu_f(v1[1])); w.w = pk2(silu_f(v1[2]), silu_f(v1[3]));
                            *(GAS v4u*)(SG2 + (size_t)row * AW + (pn - 16) * 256 + cl) = w; } }
                } }
    }
};

#define MFMA32(a, b, c) __builtin_amdgcn_mfma_f32_32x32x16_bf16((a), (b), (c), 0, 0, 0)
#define MFMA16(a, b, c) __builtin_amdgcn_mfma_f32_16x16x32_bf16((a), (b), (c), 0, 0, 0)
typedef short v4i16_t __attribute__((ext_vector_type(4)));
__device__ __forceinline__ int crow(int r, int hi) { return (r & 3) + 8 * (r >> 2) + 4 * hi; }
__device__ __forceinline__ s16x4 vtr(const LAS unsigned char* p) { return __builtin_bit_cast(s16x4, __builtin_amdgcn_ds_read_tr16_b64_v4i16((LAS v4i16_t*)p)); }
__device__ __forceinline__ bf16x8 pack8(const f32x16& x, int s) {
    v4u p; p.x = cvtpk(x[8 * s], x[8 * s + 1]); p.y = cvtpk(x[8 * s + 2], x[8 * s + 3]); p.z = cvtpk(x[8 * s + 4], x[8 * s + 5]); p.w = cvtpk(x[8 * s + 6], x[8 * s + 7]);
    return __builtin_bit_cast(bf16x8, p);
}
__device__ __forceinline__ bf16x8 cat44(s16x4 lo, s16x4 hi) { return (bf16x8){lo[0], lo[1], lo[2], lo[3], hi[0], hi[1], hi[2], hi[3]}; }
__device__ __forceinline__ float half_swap_max(float m) { auto rr = __builtin_amdgcn_permlane32_swap(__float_as_uint(m), __float_as_uint(m), false, false); return fmaxf(__uint_as_float(rr[0]), __uint_as_float(rr[1])); }
__device__ __forceinline__ float half_swap_sum(float m) { auto rr = __builtin_amdgcn_permlane32_swap(__float_as_uint(m), __float_as_uint(m), false, false); return __uint_as_float(rr[0]) + __uint_as_float(rr[1]); }

constexpr int AT_KSTR = 2064, AT_VDH = 8256, AT_BLK = 8 * AT_KSTR + 2 * AT_VDH  , AT_VOFF = 8 * AT_KSTR;
constexpr int AT_RING = 0, AT_BT = 3 * AT_BLK  , AT_BTW = 800, AT_WS = AT_BT + 8 * AT_BTW  , AT_OST = AT_WS + 2048  , AT_END = AT_OST + 8 * 4096;
static_assert(AT_END <= LDS_BYTES, "attention LDS");
constexpr float NEGBIG = -1.0e30f;

__device__ __forceinline__ void attn_dma_block(Frame& F, int gid, int lane) {
    const bf16* Kb = (const bf16*)(F.ws + WS_K); const bf16* Vb = (const bf16*)(F.ws + WS_V);
    const int bk = gid >> 4, kvh = bk & 3, b = bk >> 2, qb = gid & 15; const size_t row0 = (size_t)b * SEQ + qb * 128;
    LAS unsigned char* blk = F.lds + AT_RING + (gid % 3) * AT_BLK; const int w = F.wave;
#pragma unroll
    for (int i = 0; i < 2; ++i) {
        __builtin_amdgcn_global_load_lds((const GAS unsigned*)(Kb + (row0 + 64 * i + lane) * KVW + kvh * 64 + w * 8), (LAS unsigned*)(blk + w * AT_KSTR + i * 1024), 16, 0, 0);
        const int p = 2 * w + i, dh = p >> 3, kg = p & 7;
        __builtin_amdgcn_global_load_lds((const GAS unsigned*)(Vb + (row0 + 16 * kg + (lane >> 2)) * KVW + kvh * 64 + dh * 32 + (lane & 3) * 8), (LAS unsigned*)(blk + AT_VOFF + dh * AT_VDH + kg * 1024), 16, 0, 0); }
}
__device__ __forceinline__ void attn_prompt_unit(Frame& F, int gid, int lane) {
    const int r32 = lane & 31, hi = lane >> 5, wid = F.wave;
    const bf16* Qb = (const bf16*)(F.ws + WS_Q); const bf16* SG = (const bf16*)(F.ws + WS_SG); bf16* OG = (bf16*)(F.ws + WS_OG);
    const int bk = gid >> 4, kvh = bk & 3, b = bk >> 2, qb = gid & 15;
    const int head = kvh * 8 + wid; const size_t rowbase = (size_t)b * SEQ; const int t0 = qb * 128;
    LAS unsigned char* lds = F.lds;
    const unsigned tboff = (unsigned)AT_BT + (unsigned)(wid & 7) * AT_BTW + (((unsigned)lane & 31u) + 4u * (1u - (((unsigned)lane >> 5) & 1u))) * 4u;
    LAS float* wsf = (LAS float*)(lds + AT_WS) + wid * 64;
    LAS unsigned short* stg = (LAS unsigned short*)(lds + AT_OST + wid * 4096);
    const float sinkv = F.sk[head] * LOG2E;
    const int slotc = (gid % 3) * AT_BLK, slotp = ((gid + 2) % 3) * AT_BLK;
    const int vlane = (4 * hi + ((lane & 15) >> 2)) * 64 + ((lane >> 4) & 1) * 32 + (lane & 3) * 8;
    const int ktmin = (qb == 0) ? 4 : 0;
    const bf16* Qw = Qb + (rowbase + t0 + r32) * AW + head * 64 + hi * 8;
    bf16x8 qr[4];
#pragma unroll
    for (int d0 = 0; d0 < 4; ++d0) qr[d0] = *(const GAS bf16x8*)(Qw + d0 * 16);
    for (int qt = 0; qt < 4; ++qt) {
        f32x16 p[5];
        float mx0 = sinkv, mx1 = sinkv, mx2 = sinkv, mx3 = sinkv;
        unsigned tbo = tboff; asm volatile("" : "+v"(tbo));
#pragma unroll
        for (int j = 0; j < 5; ++j) { const int kt = qt + j;
            f32x16 a;
#pragma unroll
            for (int r = 0; r < 16; ++r) a[r] = *(const LAS float*)(lds + tbo + 4 * (159 - 32 * j - ((r & 3) + 8 * (r >> 2))));
            if (kt >= ktmin) {
                const LAS unsigned char* kb = lds + ((kt >> 2) ? slotc : slotp) + hi * AT_KSTR + ((kt & 3) * 32 + r32) * 16;
#pragma unroll
                for (int d0 = 0; d0 < 4; ++d0) { const bf16x8 kf = *(const LAS bf16x8*)(kb + 2 * d0 * AT_KSTR); a = MFMA32(kf, qr[d0], a); }
            } else {
#pragma unroll
                for (int r = 0; r < 16; ++r) a[r] = NEGBIG;
            }
#pragma unroll
            for (int r = 0; r < 16; r += 4) { mx0 = fmaxf(mx0, a[r]); mx1 = fmaxf(mx1, a[r + 1]); mx2 = fmaxf(mx2, a[r + 2]); mx3 = fmaxf(mx3, a[r + 3]); }
            p[j] = a; }
        asm volatile("" ::: "memory");
        if (qt < 3) {
#pragma unroll
            for (int d0 = 0; d0 < 4; ++d0) qr[d0] = *(const GAS bf16x8*)(Qw + (size_t)(qt + 1) * 32 * AW + d0 * 16); }
        v4u gv[4];
#pragma unroll
        for (int i = 0; i < 4; ++i) gv[i] = *(const GAS v4u*)(SG + (rowbase + t0 + qt * 32 + i * 8 + (lane >> 3)) * AW + head * 64 + (lane & 7) * 8);
        asm volatile("" ::: "memory");
        const float mx = half_swap_max(fmaxf(fmaxf(mx0, mx1), fmaxf(mx2, mx3)));
        float l0 = 0.f, l1 = 0.f, l2 = 0.f, l3 = 0.f;
        bf16x8 pa[5][2];
#pragma unroll
        for (int j = 0; j < 5; ++j) {
#pragma unroll
            for (int r = 0; r < 16; r += 4) { const float e0 = __builtin_amdgcn_exp2f(p[j][r] - mx), e1 = __builtin_amdgcn_exp2f(p[j][r + 1] - mx), e2 = __builtin_amdgcn_exp2f(p[j][r + 2] - mx), e3 = __builtin_amdgcn_exp2f(p[j][r + 3] - mx);
                p[j][r] = e0; p[j][r + 1] = e1; p[j][r + 2] = e2; p[j][r + 3] = e3; l0 += e0; l1 += e1; l2 += e2; l3 += e3; }
            pa[j][0] = pack8(p[j], 0); pa[j][1] = pack8(p[j], 1); }
        const float l = half_swap_sum((l0 + l1) + (l2 + l3)) + __builtin_amdgcn_exp2f(sinkv - mx);
        f32x16 o[2]; o[0] = f32x16{}; o[1] = f32x16{};
#pragma unroll
        for (int j = 0; j < 5; ++j) { const int kt = qt + j;
            if (kt >= ktmin) {
                const LAS unsigned char* vb = lds + ((kt >> 2) ? slotc : slotp) + AT_VOFF + (kt & 3) * 2048 + vlane;
#pragma unroll
                for (int s = 0; s < 2; ++s) {
#pragma unroll
                    for (int d0 = 0; d0 < 2; ++d0) { const LAS unsigned char* vp = vb + d0 * AT_VDH + s * 1024;
                        const s16x4 lo = vtr(vp), hh = vtr(vp + 512); o[d0] = MFMA32(pa[j][s], cat44(lo, hh), o[d0]); } } } }
        if (hi == 0) wsf[32 + r32] = l;
        LDS_WAIT(); asm volatile("" ::: "memory");
#pragma unroll
        for (int r = 0; r < 16; ++r) { const int orow = crow(r, hi); const float rl = __builtin_amdgcn_rcpf(wsf[32 + orow]);
            stg[orow * 64 + r32] = (unsigned short)f2bf(o[0][r] * rl); stg[orow * 64 + 32 + r32] = (unsigned short)f2bf(o[1][r] * rl); }
        LDS_WAIT(); asm volatile("" ::: "memory");
#pragma unroll
        for (int i = 0; i < 4; ++i) { const int row = i * 8 + (lane >> 3), ch = lane & 7; const v4u ov = *(const LAS v4u*)(stg + row * 64 + ch * 8);
            const size_t gi = (rowbase + t0 + qt * 32 + row) * AW + head * 64 + ch * 8; v4u w;
            w.x = pk2(bflo(ov.x) * bflo(gv[i].x), bfhi(ov.x) * bfhi(gv[i].x)); w.y = pk2(bflo(ov.y) * bflo(gv[i].y), bfhi(ov.y) * bfhi(gv[i].y));
            w.z = pk2(bflo(ov.z) * bflo(gv[i].z), bfhi(ov.z) * bfhi(gv[i].z)); w.w = pk2(bflo(ov.w) * bflo(gv[i].w), bfhi(ov.w) * bfhi(gv[i].w));
            *(GAS v4u*)(OG + gi) = w; }
        LDS_WAIT(); asm volatile("" ::: "memory");
    }
}
__device__ __forceinline__ void p2_prompt_attention(Frame& F) {
    const int lane = lane_id();
    const int per = (1024 + F.G - 1) / F.G, u0 = F.vcu * per, u1 = (u0 + per < 1024) ? u0 + per : 1024;
    if (u0 >= u1) return;
    const float* BT = (const float*)(F.ws + WS_BT);
    if ((u0 & 15) != 0) attn_dma_block(F, u0 - 1, lane);
    attn_dma_block(F, u0, lane);
    int head_cur = -1;
    for (int u = u0; u < u1; ++u) {
        const int head = ((u >> 4) & 3) * 8 + F.wave;
        if (head != head_cur) { head_cur = head; LAS float* tbw = (LAS float*)(F.lds + AT_BT + F.wave * AT_BTW);
#pragma unroll
            for (int i = 0; i < 4; ++i) { const int k = lane + 64 * i, rel = k - 35; if (k < 200) tbw[k] = (rel >= 0 && rel < 128) ? BT[head * 128 + rel] : NEGBIG; } }
        asm volatile("s_waitcnt vmcnt(0) lgkmcnt(0)" ::: "memory"); __syncthreads();
        if (u + 1 < u1) attn_dma_block(F, u + 1, lane);
        attn_prompt_unit(F, u, lane);
    }
    asm volatile("s_waitcnt vmcnt(0) lgkmcnt(0)" ::: "memory"); __syncthreads();
}

constexpr int AS_K = 0, AS_V = 33280, AS_Q = 66048, AS_P = 68096;
__device__ __forceinline__ void attn_sample_unit(Frame& F, int s, int kvh) {
    const int tid = cur_tid(F), lane = lane_id(), wid = F.wave;
    LAS float* Kf = (LAS float*)(F.lds + AS_K); LAS float* Vf = (LAS float*)(F.lds + AS_V); LAS float* qf = (LAS float*)(F.lds + AS_Q) + wid * 64; LAS float* pb = (LAS float*)(F.lds + AS_P) + wid * 128;
    const bf16* Qb = (const bf16*)(F.ws + WS_Q); const bf16* SG = (const bf16*)(F.ws + WS_SG); bf16* OG = (bf16*)(F.ws + WS_OG); const float* BT = (const float*)(F.ws + WS_BT);
    const int head = kvh * 8 + wid; const size_t row = (size_t)MPR + s;
#pragma unroll
    for (int i = 0; i < 4; ++i) { const int idx = tid + 512 * i, jj = idx >> 4, c4 = idx & 15;
        const float* ksrc = (jj < 127) ? F.ck + ((size_t)(s * 128 + jj + 1) * 4 + kvh) * 64 : F.out + O_KS + ((size_t)(s * 128 + 127) * 4 + kvh) * 64;
        const float* vsrc = (jj < 127) ? F.cv + ((size_t)(s * 128 + jj + 1) * 4 + kvh) * 64 : F.out + O_VS + ((size_t)(s * 128 + 127) * 4 + kvh) * 64;
        const f32x4 kv = *(const GAS f32x4*)(ksrc + c4 * 4), vv = *(const GAS f32x4*)(vsrc + c4 * 4);
        Kf[jj * 65 + c4 * 4 + 0] = kv[0]; Kf[jj * 65 + c4 * 4 + 1] = kv[1]; Kf[jj * 65 + c4 * 4 + 2] = kv[2]; Kf[jj * 65 + c4 * 4 + 3] = kv[3];
        *(LAS f32x4*)(Vf + jj * 64 + c4 * 4) = vv; }
    qf[lane] = bf2f(Qb[row * AW + head * 64 + lane]);
    __syncthreads();
    float s0 = 0.f, s1 = 0.f;
#pragma unroll 8
    for (int d = 0; d < 64; ++d) { const float q = qf[d]; s0 += q * Kf[lane * 65 + d]; s1 += q * Kf[(lane + 64) * 65 + d]; }
    s0 += BT[head * 128 + 127 - lane]; s1 += BT[head * 128 + 63 - lane];
    const float sinkv = F.sk[head] * LOG2E;
    const float mx = fmaxf(wave_max(fmaxf(s0, s1)), sinkv);
    const float p0 = __builtin_amdgcn_exp2f(s0 - mx), p1 = __builtin_amdgcn_exp2f(s1 - mx);
    const float l = wave_sum(p0 + p1) + __builtin_amdgcn_exp2f(sinkv - mx);
    pb[lane] = p0; pb[lane + 64] = p1;
    LDS_WAIT(); asm volatile("" ::: "memory");
    float o = 0.f;
#pragma unroll 8
    for (int jj = 0; jj < 128; ++jj) o += pb[jj] * Vf[jj * 64 + lane];
    const size_t gi = row * AW + head * 64 + lane;
    OG[gi] = (unsigned short)f2bf(o / l * bf2f(SG[gi]));
    __syncthreads();
}
__device__ __forceinline__ void p2_attention(Frame& F) {
    p2_prompt_attention(F);
#ifndef DUP_AS
#define DUP_AS 1
#endif
    for (int rep = 0; rep < DUP_AS; ++rep)
    for (int u = F.vcu; u < NS * 4; u += F.G) attn_sample_unit(F, u >> 2, u & 3);
}

__device__ __forceinline__ unsigned off_a(unsigned row, unsigned ch) { return 2048u * (row >> 3) + 512u * (ch >> 2) + 64u * (row & 7) + 16u * ((ch & 3) ^ ((row >> 2) & 3)); }
__device__ __forceinline__ unsigned tr_base(unsigned lane, unsigned t) {
    const unsigned h = lane >> 5, blk = (lane >> 4) & 1, q = (lane & 15) >> 2, p = lane & 3;
    return 2048u * h + 64u * (4 * t + q) + 16u * ((2 * blk + (p >> 1)) ^ (2 * h + t)) + 8u * (p & 1);
}
constexpr int RT_QS = 528;
constexpr int RT_Q = 0, RT_K = 33792, RT_V = 66560, RT_P = 82944, RT_X = 92160, RT_O = 124928, RT_END = 141312;
constexpr int RT_PS = 144;
static_assert(RT_END <= LDS_BYTES, "retention LDS");
constexpr int RC = 64;

__device__ __forceinline__ void ret_sample_unit(Frame& F, int s, int h);
__device__ __forceinline__ void ret_prompt_unit(Frame& F, int b, int h, int es, int su0, int ss0, int su1, int ss1) {
    int tid_ = cur_tid(F); asm volatile("" : "+v"(tid_));
    const int tid = tid_, lane = tid & 63, r32 = lane & 31, hi = lane >> 5, wid = F.wave, ec = wid & 3, dh = wid >> 2;
    LAS unsigned char* lds = F.lds;
    const bf16* Qr = (const bf16*)(F.ws + WS_Q); const bf16* Kr = Qr + (size_t)MPAD * DM; const bf16* Vr = (const bf16*)(F.ws + WS_SG);
    bf16* ORAW = (bf16*)(F.ws + WS_ORAW); float* STAT = (float*)(F.ws + WS_STAT);
    const size_t rowbase = (size_t)b * SEQ;
    const float gam = 1.0f - exp2f(-5.0f - (float)h);
    const float gCm1 = exp2f(log2f(gam) * (float)(RC - 1));
    f32x16 R[4];
#pragma unroll
    for (int dt = 0; dt < 4; ++dt) R[dt] = f32x16{};
    v4u sq[4], sk[4], sv[2];
    const int qrow = tid >> 5, qch = tid & 31;
    const int vrow = tid >> 4, vch = tid & 15;
#define RT_LOAD(step) do { const size_t tok0_ = rowbase + (size_t)(step) * RC; \
    _Pragma("unroll") for (int i_ = 0; i_ < 4; ++i_) { const size_t g_ = (tok0_ + qrow + 16 * i_) * DM + h * 256 + qch * 8; sq[i_] = *(const GAS v4u*)(Qr + g_); sk[i_] = *(const GAS v4u*)(Kr + g_); } \
    _Pragma("unroll") for (int i_ = 0; i_ < 2; ++i_) sv[i_] = *(const GAS v4u*)(Vr + (tok0_ + vrow + 32 * i_) * AW + h * 512 + es * 128 + vch * 8); } while (0)
#define RT_WRITE() do { \
    _Pragma("unroll") for (int i_ = 0; i_ < 4; ++i_) { const int row_ = qrow + 16 * i_; *(LAS v4u*)(lds + RT_Q + row_ * RT_QS + qch * 16) = sq[i_]; \
        *(LAS v4u*)(lds + RT_K + (qch >> 4) * 16384 + off_a(row_, qch & 15)) = sk[i_]; } \
    _Pragma("unroll") for (int i_ = 0; i_ < 2; ++i_) { const int row_ = vrow + 32 * i_; *(LAS v4u*)(lds + RT_V + off_a(row_, vch)) = sv[i_]; } } while (0)
#define RT_FLUSH(stp) do { LAS unsigned short* stg = (LAS unsigned short*)(lds + RT_O + wid * 2048); \
            const int orow = lane >> 1, half = lane & 1; \
            const v4u a0 = *(const LAS v4u*)(stg + orow * 32 + half * 16), a1 = *(const LAS v4u*)(stg + orow * 32 + half * 16 + 8); \
            float sm = 0.f, s2m = 0.f; \
            RT_ACC(a0.x); RT_ACC(a0.y); RT_ACC(a0.z); RT_ACC(a0.w); RT_ACC(a1.x); RT_ACC(a1.y); RT_ACC(a1.z); RT_ACC(a1.w); \
            sm += __shfl_xor(sm, 1); s2m += __shfl_xor(s2m, 1); \
            const size_t grow = rowbase + (size_t)(stp) * RC + 32 * dh + orow; \
            bf16* op = ORAW + grow * AW + h * 512 + es * 128 + ec * 32 + half * 16; \
            *(GAS v4u*)op = a0; *(GAS v4u*)(op + 8) = a1; \
            STAT[((grow * 4 + h) * 16 + es * 4 + ec) * 2 + half] = half ? s2m : sm; } while (0)
#define RT_ACC(w) do { const float x0_ = bflo(w), x1_ = bfhi(w); sm += x0_ + x1_; s2m += x0_ * x0_ + x1_ * x1_; } while (0)
    RT_LOAD(0);
    const int NSTEP = SEQ / RC;
    for (int step = 0; step < NSTEP; ++step) {
        RT_WRITE();
        __syncthreads();
        if (step > 0) RT_FLUSH(step - 1);
        RT_LOAD((step + 1 < NSTEP) ? step + 1 : step);
        const unsigned k16 = 2048u * ((lane & 15) >> 3) + 64u * (lane & 7) + 16u * ((lane >> 4) ^ (((lane & 15) >> 2) & 3));
#pragma unroll
        for (int tt = 0; tt < 2; ++tt) { const int T = 2 * wid + tt, jt = T >> 2, it = T & 3; const int l15 = lane & 15, g = lane >> 4;
            f32x4 a = {0.f, 0.f, 0.f, 0.f};
            if (jt <= it) {
#pragma unroll
                for (int s = 0; s < 8; ++s) {
                    const bf16x8 ka = *(const LAS bf16x8*)(lds + RT_K + k16 + 4096 * jt + (s >> 2) * 16384 + 512 * (s & 3));
                    const bf16x8 qb = *(const LAS bf16x8*)(lds + RT_Q + (16 * it + l15) * RT_QS + (32 * s + 8 * g) * 2);
                    a = MFMA16(ka, qb, a); }
            }
            const int i = 16 * it + l15, j0 = 16 * jt + 4 * g;
            v2u w; w.x = pk2((i >= j0) ? a[0] : 0.f, (i >= j0 + 1) ? a[1] : 0.f); w.y = pk2((i >= j0 + 2) ? a[2] : 0.f, (i >= j0 + 3) ? a[3] : 0.f);
            *(LAS v2u*)(lds + RT_P + i * RT_PS + j0 * 2) = w; }
        __builtin_amdgcn_sched_barrier(0);
        f32x16 part;
#pragma unroll
        for (int pass = 0; pass < 2; ++pass) { const int it = (pass == 0) ? (1 - dh) : dh;
            part = f32x16{};
#pragma unroll
            for (int dt = 0; dt < 4; ++dt)
#pragma unroll
                for (int s2 = 0; s2 < 2; ++s2) { const bf16x8 rb = pack8(R[dt], s2); const int dcol = 128 * dh + 32 * dt + 16 * s2 + 4 * hi;
                    const LAS unsigned char* qp = lds + RT_Q + (32 * it + r32) * RT_QS + dcol * 2;
                    const s16x4 lo = *(const LAS s16x4*)qp, hh = *(const LAS s16x4*)(qp + 16);
                    part = MFMA32(cat44(lo, hh), rb, part); }
            if (pass == 0) { LAS float* xo = (LAS float*)(lds + RT_X + wid * 4096);
#pragma unroll
                for (int r = 0; r < 16; ++r) xo[r * 64 + lane] = part[r];
                __builtin_amdgcn_sched_barrier(0); } }
        __syncthreads();
        const unsigned trb0 = tr_base(lane, 0), trb1 = tr_base(lane, 1);
        bf16x8 vf[4];
#pragma unroll
        for (int ks = 0; ks < 4; ++ks) vf[ks] = cat44(vtr(lds + RT_V + trb0 + 512 * ec + 4096 * ks), vtr(lds + RT_V + trb1 + 512 * ec + 4096 * ks));
        __builtin_amdgcn_sched_barrier(0);
        f32x16 oi = f32x16{};
#pragma unroll
        for (int jt = 0; jt < 2; ++jt) if (jt <= dh) {
#pragma unroll
            for (int s2 = 0; s2 < 2; ++s2) { const bf16x8 pa = *(const LAS bf16x8*)(lds + RT_P + (32 * dh + r32) * RT_PS + (32 * jt + 16 * s2 + 8 * hi) * 2);
                oi = MFMA32(pa, vf[2 * jt + s2], oi); } }
        __builtin_amdgcn_sched_barrier(0);
        {   const LAS float* xi = (const LAS float*)(lds + RT_X + (wid ^ 4) * 4096);
            LAS unsigned short* stg = (LAS unsigned short*)(lds + RT_O + wid * 2048);
#pragma unroll
            for (int r = 0; r < 16; ++r) {
                const float inter = part[r] + xi[r * 64 + lane];
                const float v = oi[r] + gam * inter;
                stg[crow(r, hi) * 32 + r32] = (unsigned short)f2bf(v); }
        }
        __builtin_amdgcn_sched_barrier(0);
#pragma unroll
        for (int dt = 0; dt < 4; ++dt)
#pragma unroll
            for (int r = 0; r < 16; ++r) R[dt][r] *= gam;
#pragma unroll
        for (int ks = 0; ks < 4; ++ks) { const LAS unsigned char* kb = lds + RT_K + dh * 16384;
            const bf16x8 vk = cat44(vtr(lds + RT_V + trb0 + 512 * ec + 4096 * ks), vtr(lds + RT_V + trb1 + 512 * ec + 4096 * ks));
#pragma unroll
            for (int dt = 0; dt < 4; ++dt) { const bf16x8 kf = cat44(vtr(kb + trb0 + 512 * dt + 4096 * ks), vtr(kb + trb1 + 512 * dt + 4096 * ks));
                R[dt] = MFMA32(kf, vk, R[dt]); } }
#pragma unroll
        for (int dt = 0; dt < 4; ++dt)
#pragma unroll
            for (int r = 0; r < 16; ++r) R[dt][r] *= gCm1;
        __syncthreads();
        if (step == ss0) ret_sample_unit(F, su0 >> 2, su0 & 3);
        if (step == ss1) ret_sample_unit(F, su1 >> 2, su1 & 3);
    }
    RT_FLUSH(NSTEP - 1);
#undef RT_FLUSH
#undef RT_ACC
    const int lane2 = lane_id();
    float* rp = F.out + O_RP + ((size_t)(b * 4 + h) * 256 + 128 * dh + 4 * (lane2 >> 5)) * 512 + es * 128 + ec * 32 + (lane2 & 31);
#pragma unroll
    for (int dt = 0; dt < 4; ++dt)
#pragma unroll
        for (int r = 0; r < 16; ++r) rp[(size_t)(32 * dt + (r & 3) + 8 * (r >> 2)) * 512] = R[dt][r];
#undef RT_LOAD
#undef RT_WRITE
}

constexpr int RS_Q = 0, RS_K = 1024, RS_RED = 2048, RS_ST = 2048 + 8192;
__device__ __forceinline__ void ret_sample_unit(Frame& F, int s, int h) {
    const int tid = cur_tid(F), lane = lane_id(), wid = F.wave;
    const bf16* Qr = (const bf16*)(F.ws + WS_Q); const bf16* Kr = Qr + (size_t)MPAD * DM; const bf16* Vr = (const bf16*)(F.ws + WS_SG); const bf16* SG2 = (const bf16*)(F.ws + WS_OG);
    bf16* OG2 = (bf16*)(F.ws + WS_ORAW);
    LAS float* qf = (LAS float*)(F.lds + RS_Q); LAS float* kf = (LAS float*)(F.lds + RS_K); LAS float* red = (LAS float*)(F.lds + RS_RED); LAS float* stt = (LAS float*)(F.lds + RS_ST);
    const size_t row = (size_t)MPR + s;
    const float gamma = 1.0f - exp2f(-5.0f - (float)h);
    if (tid < 256) { qf[tid] = bf2f(Qr[row * DM + h * 256 + tid]); kf[tid] = bf2f(Kr[row * DM + h * 256 + tid]); }
    __syncthreads();
    float qk = 0.f;
#pragma unroll
    for (int i = 0; i < 4; ++i) qk += qf[lane + 64 * i] * kf[lane + 64 * i];
    qk = wave_sum(qk);
    const int e4 = tid & 127, dg = tid >> 7;
    const v2u vw = *(const GAS v2u*)(Vr + row * AW + h * 512 + e4 * 4);
    const f32x4 v = {bflo(vw.x), bfhi(vw.x), bflo(vw.y), bfhi(vw.y)};
    const float* Rin = F.st + ((size_t)(s * 4 + h) * 256) * 512 + e4 * 4; float* Rout = F.out + O_RS + ((size_t)(s * 4 + h) * 256) * 512 + e4 * 4;
    f32x4 acc = {0.f, 0.f, 0.f, 0.f};
#pragma unroll 8
    for (int i = 0; i < 64; ++i) { const int d = dg + 4 * i; const f32x4 r = *(const GAS f32x4*)(Rin + (size_t)d * 512);
        const float kd = kf[d], qd = qf[d];
        *(GAS f32x4*)(Rout + (size_t)d * 512) = r * gamma + v * kd; acc += r * qd; }
    *(LAS f32x4*)(red + dg * 512 + e4 * 4) = acc;
    __syncthreads();
    float o[4] = {0.f, 0.f, 0.f, 0.f}; float sm = 0.f, s2m = 0.f;
    if (tid < 128) {
        const f32x4 t0 = *(const LAS f32x4*)(red + e4 * 4), t1 = *(const LAS f32x4*)(red + 512 + e4 * 4), t2 = *(const LAS f32x4*)(red + 1024 + e4 * 4), t3 = *(const LAS f32x4*)(red + 1536 + e4 * 4);
#pragma unroll
        for (int j = 0; j < 4; ++j) { o[j] = qk * v[j] + gamma * ((t0[j] + t1[j]) + (t2[j] + t3[j])); sm += o[j]; s2m += o[j] * o[j]; }
        sm = wave_sum(sm); s2m = wave_sum(s2m);
        if (lane == 0) { stt[wid * 2] = sm; stt[wid * 2 + 1] = s2m; }
    }
    __syncthreads();
    if (tid < 128) {
        const float S = stt[0] + stt[2], S2 = stt[1] + stt[3]; const float mu = S * (1.f / 512.f), var = fmaxf(S2 * (1.f / 512.f) - mu * mu, 0.f), rstd = 1.0f / sqrtf(var + EPS);
        const size_t gi = row * AW + h * 512 + e4 * 4; const v2u gw = *(const GAS v2u*)(SG2 + gi);
        v2u w; w.x = pk2((o[0] - mu) * rstd * bflo(gw.x), (o[1] - mu) * rstd * bfhi(gw.x)); w.y = pk2((o[2] - mu) * rstd * bflo(gw.y), (o[3] - mu) * rstd * bfhi(gw.y));
        *(GAS v2u*)(OG2 + gi) = w;
    }
    __syncthreads();
}
__device__ __forceinline__ void p5_retention(Frame& F) {
    if (F.G == 256) {
        const int v = F.vcu;
        ret_prompt_unit(F, v >> 4, (v >> 2) & 3, v & 3, v, (5 * v) & 31, v + 256, (5 * v + 16) & 31);
    } else {
        for (int u = F.vcu; u < 256; u += F.G) ret_prompt_unit(F, u >> 4, (u >> 2) & 3, u & 3, 0, -1, 0, -1);
        for (int u = F.vcu; u < NS * 4; u += F.G) ret_sample_unit(F, u >> 2, u & 3);
    }
}
__device__ __forceinline__ void p5b_normalize(Frame& F) {
    const int gw = F.vcu * NWAVES + F.wave, NGW = F.G * NWAVES, lane = lane_id();
    bf16* ORAW = (bf16*)(F.ws + WS_ORAW); const bf16* SG2 = (const bf16*)(F.ws + WS_OG); const float* STAT = (const float*)(F.ws + WS_STAT);
    for (int m = gw; m < MPR; m += NGW) {
#pragma unroll
        for (int hh = 0; hh < 4; ++hh) {
            const GAS f32x4* sp = (const GAS f32x4*)(STAT + ((size_t)m * 4 + hh) * 32); float S = 0.f, S2 = 0.f;
#pragma unroll
            for (int i = 0; i < 8; ++i) { const f32x4 t = sp[i]; S += t[0] + t[2]; S2 += t[1] + t[3]; }
            const float mu = S * (1.f / 512.f), var = fmaxf(S2 * (1.f / 512.f) - mu * mu, 0.f), rstd = 1.0f / sqrtf(var + EPS);
            const size_t gi = (size_t)m * AW + hh * 512 + lane * 8; const v4u ov = *(const GAS v4u*)(ORAW + gi), gv = *(const GAS v4u*)(SG2 + gi); v4u w;
#define NRM(o_, g_) pk2((bflo(o_) - mu) * rstd * bflo(g_), (bfhi(o_) - mu) * rstd * bfhi(g_))
            w.x = NRM(ov.x, gv.x); w.y = NRM(ov.y, gv.y); w.z = NRM(ov.z, gv.z); w.w = NRM(ov.w, gv.w);
#undef NRM
            *(GAS v4u*)(ORAW + gi) = w; }
    }
}
__device__ __forceinline__ void p7_final_norm(Frame& F) {
    const int gw = F.vcu * NWAVES + F.wave, NGW = F.G * NWAVES, lane = lane_id();
    for (int m = gw; m < MV; m += NGW) {
        float* rowp = (m < MPR) ? F.out + O_YP + (size_t)m * DM : F.out + O_YS + (size_t)(m - MPR) * DM;
        GAS f32x4* xr = (GAS f32x4*)rowp + lane; const GAS f32x4* gr = (const GAS f32x4*)F.fg + lane;
        f32x4 v[4]; float s = 0.f;
#pragma unroll
        for (int j = 0; j < 4; ++j) { v[j] = xr[64 * j]; s += (v[j].x * v[j].x + v[j].y * v[j].y) + (v[j].z * v[j].z + v[j].w * v[j].w); }
        const float rstd = 1.0f / sqrtf(wave_sum(s) * (1.f / DM) + EPS);
#pragma unroll
        for (int j = 0; j < 4; ++j) xr[64 * j] = v[j] * rstd * gr[64 * j];
    }
}

template <int K>
__device__ __forceinline__ void sgemm_unit(const bf16* A, int lda, const bf16* Bt, int n0, int n1, int wave, int lane, f32x4& c0, f32x4& c1) {
    const int l15 = lane & 15, g = lane >> 4;
    const bf16* ap = A + (size_t)(16 * wave + l15) * lda + 8 * g;
    const bf16* b0 = Bt + (size_t)(n0 + l15) * K + 8 * g; const bf16* b1 = Bt + (size_t)(n1 + l15) * K + 8 * g;
    c0 = f32x4{0.f, 0.f, 0.f, 0.f}; c1 = f32x4{0.f, 0.f, 0.f, 0.f};
#pragma unroll 8
    for (int s = 0; s < K / 32; ++s) { const bf16x8 a = *(const GAS bf16x8*)(ap + 32 * s), x = *(const GAS bf16x8*)(b0 + 32 * s), y = *(const GAS bf16x8*)(b1 + 32 * s);
        c0 = MFMA16(a, x, c0); c1 = MFMA16(a, y, c1); }
}
__device__ __forceinline__ void p1_sample(Frame& F) {
    const int lane = lane_id(), l15 = lane & 15, g = lane >> 4;
    const bf16* XN = (const bf16*)(F.ws + WS_XN) + (size_t)MPR * DM; const bf16* W = (const bf16*)(F.ws + WS_WINA);
    bf16* Q = (bf16*)(F.ws + WS_Q); bf16* SG = (bf16*)(F.ws + WS_SG);
    for (int u = F.vcu; u < ATT_IN / 32; u += F.G) { f32x4 c[2]; const int n0 = 32 * u;
        sgemm_unit<DM>(XN, DM, W, n0, n0 + 16, F.wave, lane, c[0], c[1]);
#pragma unroll
        for (int t = 0; t < 2; ++t) { const int col = n0 + 16 * t + l15;
#pragma unroll
            for (int r = 0; r < 4; ++r) { const int s = 16 * F.wave + 4 * g + r; const float v = c[t][r]; const size_t row = (size_t)MPR + s;
                if (col < 2048) Q[row * AW + col] = (unsigned short)f2bf(v * C2);
                else if (col < 2304) F.out[O_KS + (size_t)(s * 128 + 127) * 256 + (col - 2048)] = v;
                else if (col < 2560) F.out[O_VS + (size_t)(s * 128 + 127) * 256 + (col - 2304)] = v;
                else SG[row * AW + (col - 2560)] = (unsigned short)f2bf(silu_f(v)); } } }
}
__device__ __forceinline__ void p3_sample(Frame& F) {
    const int lane = lane_id(), l15 = lane & 15, g = lane >> 4;
    const bf16* OG = (const bf16*)(F.ws + WS_OG) + (size_t)MPR * AW; const bf16* W = (const bf16*)(F.ws + WS_WOA);
    float* X1 = (float*)(F.ws + WS_X1); bf16* XN2 = (bf16*)(F.ws + WS_XN); float* SSQS = (float*)(F.ws + WS_SSQ1) + (size_t)MPR * 16;
    for (int u = F.vcu; u < DM / 32; u += F.G) { f32x4 c[2]; const int n0 = 32 * u;
        sgemm_unit<AW>(OG, AW, W, n0, n0 + 16, F.wave, lane, c[0], c[1]);
#pragma unroll
        for (int t = 0; t < 2; ++t) { const int col = n0 + 16 * t + l15;
#pragma unroll
            for (int r = 0; r < 4; ++r) { const int s = 16 * F.wave + 4 * g + r; const size_t row = (size_t)MPR + s;
                const float x1 = F.xs[(size_t)s * DM + col] + c[t][r]; X1[row * DM + col] = x1; XN2[row * DM + col] = (unsigned short)f2bf(x1);
                float sq = x1 * x1; sq += __shfl_xor(sq, 1); sq += __shfl_xor(sq, 2); sq += __shfl_xor(sq, 4); sq += __shfl_xor(sq, 8);
                if (l15 == 0) SSQS[s * 64 + 2 * u + t] = sq; } } }
}
__device__ __forceinline__ void p4_sample(Frame& F) {
    const int lane = lane_id(), l15 = lane & 15, g = lane >> 4;
    const bf16* XN2 = (const bf16*)(F.ws + WS_XN) + (size_t)MPR * DM; const bf16* W = (const bf16*)(F.ws + WS_WINR);
    const float* SSQS = (const float*)(F.ws + WS_SSQ1) + (size_t)MPR * 16; const float* COS = (const float*)(F.ws + WS_COS) + 2048 * 128; const float* SIN = (const float*)(F.ws + WS_SIN) + 2048 * 128;
    bf16* Qr = (bf16*)(F.ws + WS_Q); bf16* Kr = Qr + (size_t)MPAD * DM; bf16* Vr = (bf16*)(F.ws + WS_SG); bf16* SG2 = (bf16*)(F.ws + WS_OG);
    for (int u = F.vcu; u < 192; u += F.G) {
        float rstd[4];
#pragma unroll
        for (int r = 0; r < 4; ++r) { const int s = 16 * F.wave + 4 * g + r; const GAS f32x4* sp = (const GAS f32x4*)(SSQS + s * 64) + (l15 & 3) * 4; float a = 0.f;
#pragma unroll
            for (int i = 0; i < 4; ++i) { const f32x4 t = sp[i]; a += (t[0] + t[1]) + (t[2] + t[3]); }
            a += __shfl_xor(a, 1); a += __shfl_xor(a, 2); rstd[r] = 1.0f / sqrtf(a * (1.f / DM) + EPS); }
        f32x4 c0, c1;
        if (u < 64) { const int hq = u >> 3, j = u & 7, n0 = 256 * hq + 16 * j, d = 16 * j + l15;
            sgemm_unit<DM>(XN2, DM, W, n0, n0 + 128, F.wave, lane, c0, c1);
            const float cc = COS[d], ss = SIN[d], sc = (hq < 4) ? 1.0f : 0.0625f; bf16* dst = (hq < 4) ? Qr : Kr;
#pragma unroll
            for (int r = 0; r < 4; ++r) { const int s = 16 * F.wave + 4 * g + r; const size_t row = (size_t)MPR + s; const float x1 = c0[r] * rstd[r] * sc, x2 = c1[r] * rstd[r] * sc;
                dst[row * DM + (hq & 3) * 256 + d] = (unsigned short)f2bf(x1 * cc - x2 * ss); dst[row * DM + (hq & 3) * 256 + 128 + d] = (unsigned short)f2bf(x1 * ss + x2 * cc); }
        } else { const int n0 = 2048 + 32 * (u - 64);
            sgemm_unit<DM>(XN2, DM, W, n0, n0 + 16, F.wave, lane, c0, c1);
#pragma unroll
            for (int t = 0; t < 2; ++t) { const int col = n0 + 16 * t + l15;
#pragma unroll
                for (int r = 0; r < 4; ++r) { const int s = 16 * F.wave + 4 * g + r; const size_t row = (size_t)MPR + s; const float v = (t == 0 ? c0[r] : c1[r]) * rstd[r];
                    if (col < 4096) Vr[row * AW + (col - 2048)] = (unsigned short)f2bf(v); else SG2[row * AW + (col - 4096)] = (unsigned short)f2bf(silu_f(v)); } } }
    }
}
__device__ __forceinline__ void p6_sample(Frame& F) {
    const int lane = lane_id(), l15 = lane & 15, g = lane >> 4;
    const bf16* OG2 = (const bf16*)(F.ws + WS_ORAW) + (size_t)MPR * AW; const bf16* W = (const bf16*)(F.ws + WS_WOR); const float* X1 = (const float*)(F.ws + WS_X1);
    for (int u = F.vcu; u < DM / 32; u += F.G) { f32x4 c[2]; const int n0 = 32 * u;
        sgemm_unit<AW>(OG2, AW, W, n0, n0 + 16, F.wave, lane, c[0], c[1]);
#pragma unroll
        for (int t = 0; t < 2; ++t) { const int col = n0 + 16 * t + l15;
#pragma unroll
            for (int r = 0; r < 4; ++r) { const int s = 16 * F.wave + 4 * g + r; F.out[O_YS + (size_t)s * DM + col] = X1[((size_t)MPR + s) * DM + col] + c[t][r]; } } }
}

__device__ __forceinline__ void grid_bar(const Frame& F, unsigned* cnt, unsigned target) {
    asm volatile("s_waitcnt vmcnt(0)" ::: "memory");
    __syncthreads();
    if (cur_tid(F) == 0) {
        __builtin_amdgcn_fence(__ATOMIC_RELEASE, "agent");
        asm volatile("s_waitcnt vmcnt(0)" ::: "memory");
        __hip_atomic_fetch_add(cnt, 1u, __ATOMIC_RELAXED, __HIP_MEMORY_SCOPE_AGENT);
        unsigned spins = 0;
        while (__hip_atomic_load(cnt, __ATOMIC_RELAXED, __HIP_MEMORY_SCOPE_AGENT) < target) { __builtin_amdgcn_s_sleep(2); if (++spins > (1u << 22)) break; }
        __builtin_amdgcn_fence(__ATOMIC_ACQUIRE, "agent");
        asm volatile("s_waitcnt vmcnt(0)" ::: "memory");
    }
    __syncthreads();
}
__global__ void __launch_bounds__(NTHR, 2) fwd_kernel(Args args) {
    extern __shared__ __attribute__((aligned(16))) unsigned char lds[];
    cg::grid_group grid = cg::this_grid();
    Frame F;
    F.lds = (LAS unsigned char*)lds;
    F.wave = __builtin_amdgcn_readfirstlane((int)threadIdx.x >> 6);
    F.G = gridDim.x; { const int bx = blockIdx.x; F.vcu = (F.G % 8 == 0) ? (bx % 8) * (F.G / 8) + bx / 8 : bx; }
    F.xp = args.in[0]; F.xs = args.in[1]; F.ck = args.in[2]; F.cv = args.in[3]; F.st = args.in[4]; F.ng = args.in[5]; F.fg = args.in[6]; F.rb = args.in[7];
    F.wia = args.in[8]; F.sk = args.in[9]; F.woa = args.in[10]; F.wir = args.in[11]; F.wor = args.in[12];
    F.out = args.out; F.ws = args.ws;
    const int lo = args.ph_lo, hi = args.ph_hi;
#ifndef DUP_MASK
#define DUP_MASK 0
#endif
#define REP(k) for (int rep_ = 0; rep_ < 1 + ((DUP_MASK >> (k)) & 1) * DUP_N; ++rep_)
#ifndef DUP_N
#define DUP_N 1
#endif
#ifndef PH_MASK
#define PH_MASK 0x1ff
#endif
#define IN(k) (((PH_MASK >> (k)) & 1) && lo <= (k) && (k) < hi)
#define SEAM(k) do { if (IN(k) && IN((k) + 1)) { if ((k) == 0) grid.sync(); else grid_bar(F, bar_cnt, (unsigned)(k) * (unsigned)F.G); } } while (0)
    unsigned* bar_cnt = (unsigned*)(F.ws + 256);
    if (IN(0) && blockIdx.x == 0 && cur_tid(F) == 0) __hip_atomic_store(bar_cnt, 0u, __ATOMIC_RELAXED, __HIP_MEMORY_SCOPE_AGENT);

    if (IN(0)) REP(0) { p0_prologue(F); }
    SEAM(0);
    if (IN(1)) REP(1) {
        pg8::Gemm g{(const pg8::bf16_t*)(F.ws + WS_XN), (const pg8::bf16_t*)(F.ws + WS_WINA), MPR, ATT_IN, DM};
        pg8::StaticOrder S; S.init(MPR, ATT_IN, F.G, (int)blockIdx.x);
        EpiAttnIn E{(bf16*)(F.ws + WS_Q), (bf16*)(F.ws + WS_K), (bf16*)(F.ws + WS_V), (bf16*)(F.ws + WS_SG), F.out};
        pg8::gemm_phase<EpiAttnIn, pg8::StaticOrder, true, true>(F.lds, g, S, E, F.wave);
        p1_sample(F);
    }
    SEAM(1);
    if (IN(2)) REP(2) { p2_attention(F); }
    SEAM(2);
    if (IN(3)) REP(3) {
        pg8::Gemm g{(const pg8::bf16_t*)(F.ws + WS_OG), (const pg8::bf16_t*)(F.ws + WS_WOA), MPR, DM, AW};
        pg8::StaticOrder S; S.init(MPR, DM, F.G, (int)blockIdx.x);
        EpiOutRes E{F.xp, F.xs, (bf16*)(F.ws + WS_XN), (float*)(F.ws + WS_SSQ1)};
        pg8::gemm_phase<EpiOutRes, pg8::StaticOrder, true, true>(F.lds, g, S, E, F.wave);
        p3_sample(F);
    }
    SEAM(3);
    if (IN(4)) REP(4) {
        pg8::Gemm g{(const pg8::bf16_t*)(F.ws + WS_XN), (const pg8::bf16_t*)(F.ws + WS_WINR), MPR, RET_IN, DM};
        pg8::StaticOrder S; S.init(MPR, RET_IN, F.G, (int)blockIdx.x);
        EpiRetIn E{(const float*)(F.ws + WS_SSQ1), (const float*)(F.ws + WS_COS), (const float*)(F.ws + WS_SIN), (bf16*)(F.ws + WS_Q), (bf16*)(F.ws + WS_Q) + (size_t)MPAD * DM, (bf16*)(F.ws + WS_SG), (bf16*)(F.ws + WS_OG)};
        pg8::gemm_phase<EpiRetIn, pg8::StaticOrder, true, true>(F.lds, g, S, E, F.wave);
        p4_sample(F);
    }
    SEAM(4);
    if (IN(5)) REP(5) { p5_retention(F); }
    SEAM(5);
    if (IN(6)) REP(6) { p5b_normalize(F); }
    SEAM(6);
    if (IN(7)) REP(7) {
        pg8::Gemm g{(const pg8::bf16_t*)(F.ws + WS_ORAW), (const pg8::bf16_t*)(F.ws + WS_WOR), MPR, DM, AW};
        pg8::StaticOrder S; S.init(MPR, DM, F.G, (int)blockIdx.x);
        EpiOutFinal E{(const bf16*)(F.ws + WS_XN), F.out};
        pg8::gemm_phase<EpiOutFinal, pg8::StaticOrder, true, true>(F.lds, g, S, E, F.wave);
        p6_sample(F);
    }
    SEAM(7);
    if (IN(8)) REP(8) { p7_final_norm(F); }
#undef IN
#undef SEAM
}

extern "C" void kernel_launch(void* const* d_in, const int* in_sizes, int n_in, void* d_out, int out_size, void* d_ws, size_t ws_size, hipStream_t stream) {
    static int grid = 0;
    if (grid == 0) {
        if (n_in != 13 || (size_t)out_size != O_END || ws_size < WS_END) { fprintf(stderr, "kernel_launch: unexpected shapes: n_in %d out %d ws %zu\n", n_in, out_size, ws_size); grid = -1; return; }
        int dev = 0, cus = 0, per_cu = 0;
        (void)hipGetDevice(&dev); (void)hipDeviceGetAttribute(&cus, hipDeviceAttributeMultiprocessorCount, dev);
        (void)hipFuncSetAttribute((const void*)fwd_kernel, hipFuncAttributeMaxDynamicSharedMemorySize, LDS_BYTES);
        (void)hipOccupancyMaxActiveBlocksPerMultiprocessor(&per_cu, (const void*)fwd_kernel, NTHR, LDS_BYTES);
        if (per_cu < 1) { fprintf(stderr, "kernel_launch: occupancy query says %d blocks per CU\n", per_cu); per_cu = 1; }
        (void)hipGetLastError();
        grid = cus;
        fprintf(stderr, "kernel_launch: cus %d per_cu %d grid %d\n", cus, per_cu, grid);
    }
    if (grid < 0) return;
    Args a{};
    for (int i = 0; i < 13; ++i) a.in[i] = (const float*)d_in[i];
    a.out = (float*)d_out; a.ws = (unsigned char*)d_ws; a.ph_lo = 0; a.ph_hi = 9;
    void* kargs[] = {&a};
    hipError_t e = hipLaunchCooperativeKernel((const void*)fwd_kernel, dim3(grid), dim3(NTHR), kargs, LDS_BYTES, stream);
    if (e != hipSuccess) fprintf(stderr, "kernel_launch: cooperative launch failed: %s (grid %d)\n", hipGetErrorString(e), grid);
}
```

```cpp
#include <hip/hip_runtime.h>
#include <hip/hip_cooperative_groups.h>
#include <hip/hip_bf16.h>
#include <cstdio>
#include <cstdint>
#include <cmath>
namespace cg = cooperative_groups;

namespace pg8 {
#define PG8_LAS __attribute__((address_space(3)))
typedef unsigned short bf16_t;
typedef short bf16x8 __attribute__((ext_vector_type(8)));
typedef float f32x4 __attribute__((ext_vector_type(4)));
typedef unsigned u32x4 __attribute__((ext_vector_type(4)));
constexpr int BM = 256, BK = 64, HALF = 128, HTB = HALF * BK * 2  , STAGE_BYTES = 8 * HTB, NXCD = 8, WGM = 8;

__host__ __device__ __forceinline__ int lds_byte(int r, int c) { const int st = (r >> 4) * 2 + (c >> 5), rr = r & 15, cc = c & 31, ob = rr * 64 + cc * 2; return st * 1024 + (ob ^ (((ob >> 9) & 1) << 5)); }
__host__ __device__ __forceinline__ void stage_rc(int b, int& R, int& C) { const int st = b / 1024, sb = b % 1024, swz = sb ^ (((sb >> 9) & 1) << 5); R = (st >> 1) * 16 + swz / 64; C = (st & 1) * 32 + (swz % 64) / 2; }
__host__ __device__ __forceinline__ int perm32(int rho) { const int n = rho >> 4, i = rho & 15; return 8 * (i >> 2) + 4 * n + (i & 3); }

struct Unit { int pm, pn; };
struct Gemm { const bf16_t* A; const bf16_t* Bt; int M, N, K; };

struct StaticOrder {
    int nM, nN, nwg, G, c;
    __host__ __device__ void init(int M, int N, int G_, int c_) { nM = M / BM; nN = N / BM; nwg = nM * nN; G = G_; c = c_; }
    __host__ __device__ bool next(int i, Unit& u) const {
        const long L = (long)i * G + c; if (L >= nwg) return false;
        int wgid = (int)L; { const int q = nwg / NXCD, r = nwg % NXCD, xcd = wgid % NXCD, off = wgid / NXCD; wgid = (xcd < r ? xcd * (q + 1) : r * (q + 1) + (xcd - r) * q) + off; }
        const int nig = WGM * nN, gid = wgid / nig, fm = gid * WGM, gsz = (nM - fm) < WGM ? (nM - fm) : WGM;
        u.pm = fm + ((wgid % nig) % gsz); u.pn = (wgid % nig) / gsz; return true;
    }
    __device__ __forceinline__ void a_ready(const Unit&) const {}
    __device__ __forceinline__ void done(const Unit&) const {}
};

__device__ __forceinline__ unsigned cvt_pk_bf16(float lo, float hi) { unsigned r; asm volatile("v_cvt_pk_bf16_f32 %0, %1, %2" : "=v"(r) : "v"(lo), "v"(hi)); return r; }
typedef float f32x2 __attribute__((ext_vector_type(2)));
__device__ __forceinline__ f32x2 gelu_pk(f32x2 v) {
    const f32x2 av = __builtin_elementwise_abs(v), d = av * 0.2316418882f + 1.0f;
    f32x2 t; t.x = __builtin_amdgcn_rcpf(d.x); t.y = __builtin_amdgcn_rcpf(d.y);
    f32x2 q = t * 0.5307027145f + (-0.7265760135f); q = q * t + 0.7107068705f; q = q * t + (-0.142248368f); q = q * t + 0.127414796f; q = q * t;
    const f32x2 s = (v * v) * (-0.72134752044f);
    f32x2 e; e.x = __builtin_amdgcn_exp2f(s.x); e.y = __builtin_amdgcn_exp2f(s.y);
    const f32x2 m = v * (q * e), r = v - m;
    f32x2 o; o.x = v.x < 0.f ? m.x : r.x; o.y = v.y < 0.f ? m.y : r.y; return o;
}

template <int ACT  > struct EpiBf16 {
    static constexpr bool PERM = true, AFTER_DRAIN = false; static_assert(ACT == 0 || ACT == 1, "EpiBf16: ACT is 0 (none) or 1 (gelu_pk)");
    bf16_t* O; int ldc; const float* bias; int split_cols; size_t split_stride; float scale0;
    __device__ __forceinline__ void operator()(const f32x4 (&acc)[2][2][4][2], const Unit& u, int wr, int wc, int fr, int fq) const {
        const int row0 = u.pm * BM + wr * 64 + fr; int colt = u.pn * BM; bf16_t* base = O;
        float sc = 1.f; if (split_cols) { const int t = colt / split_cols; base += (size_t)t * split_stride; colt -= t * split_cols; if (t == 0) sc = scale0; }
        const int col0 = colt + wc * 32 + 8 * fq, bcol0 = u.pn * BM + wc * 32 + 8 * fq;
        f32x4 bv[2][2];
#pragma unroll
        for (int bj = 0; bj < 2; ++bj)
#pragma unroll
            for (int n = 0; n < 2; ++n) bv[bj][n] = bias ? *(const f32x4*)(bias + bcol0 + bj * HALF + 4 * n) : (f32x4){0.f, 0.f, 0.f, 0.f};
#pragma unroll
        for (int ai = 0; ai < 2; ++ai)
#pragma unroll
            for (int m = 0; m < 4; ++m) { bf16_t* rowp = base + (size_t)(row0 + ai * HALF + m * 16) * ldc + col0;
#pragma unroll
                for (int bj = 0; bj < 2; ++bj) { f32x4 v0 = acc[ai][bj][m][0] + bv[bj][0], v1 = acc[ai][bj][m][1] + bv[bj][1];
                    if (ACT == 1) { f32x2 a = gelu_pk((f32x2){v0[0], v0[1]}), b = gelu_pk((f32x2){v0[2], v0[3]}), c = gelu_pk((f32x2){v1[0], v1[1]}), d = gelu_pk((f32x2){v1[2], v1[3]});
                        v0 = (f32x4){a.x, a.y, b.x, b.y}; v1 = (f32x4){c.x, c.y, d.x, d.y}; }
                    v0 = v0 * sc; v1 = v1 * sc; u32x4 w; w.x = cvt_pk_bf16(v0[0], v0[1]); w.y = cvt_pk_bf16(v0[2], v0[3]); w.z = cvt_pk_bf16(v1[0], v1[1]); w.w = cvt_pk_bf16(v1[2], v1[3]);
                    *(u32x4*)(rowp + bj * HALF) = w; } }
    }
};


template <class Epi, class Sched, bool ALIGN_EPI = false, bool SP2 = false>
__device__ __forceinline__ void gemm_phase(PG8_LAS unsigned char* lds, const Gemm g, const Sched& S, const Epi& E, const int wid) {
    int lane_; asm volatile("v_mbcnt_lo_u32_b32 %0, -1, 0\n\tv_mbcnt_hi_u32_b32 %0, -1, %0" : "=v"(lane_)); const int lane = lane_, tid = wid * 64 + lane, wr = wid >> 2, wc = wid & 3, fr = lane & 15, fq = lane >> 4;
    const int K = g.K, nt = K / BK;
    unsigned voffA[2], voffB[2];
#pragma unroll
    for (int i = 0; i < 2; ++i) { int R, C; stage_rc(tid * 16 + i * 8192, R, C); const int Rb = Epi::PERM ? ((R & ~31) + perm32(R & 31)) : R;
        voffA[i] = (unsigned)(R * K + C) * 2u; voffB[i] = (unsigned)(Rb * K + C) * 2u; }
    const size_t kstep = (size_t)(BK * 2);
    const size_t hstep = (size_t)HALF * K * 2;
    const size_t tstep = 2 * hstep;
    const unsigned ldsw = (unsigned)wid * 1024u;
    const int aoff = lds_byte(wr * 64 + fr, fq * 8), boff = lds_byte(wc * 32 + fr, fq * 8);
#define PG8_SA(b, h) (((b) * 2 + (h)) * HTB)
#define PG8_SB(b, h) ((4 + (b) * 2 + (h)) * HTB)
#define PG8_STAGE(bufoff, gbase, voff) do { _Pragma("unroll") for (int _i = 0; _i < 2; ++_i) \
        __builtin_amdgcn_global_load_lds((const unsigned*)((const char*)(gbase) + (voff)[_i]), (PG8_LAS unsigned*)(lds + (bufoff) + ldsw + _i * 8192), 16, 0, 0); } while (0)
#define PG8_LDA(dst, b, h) do { _Pragma("unroll") for (int m = 0; m < 4; ++m) _Pragma("unroll") for (int k = 0; k < 2; ++k) dst[m][k] = *(const PG8_LAS bf16x8*)(lds + PG8_SA(b, h) + aoff + m * 2048 + k * 1024); } while (0)
#define PG8_LDB(dst, b, h) do { _Pragma("unroll") for (int n = 0; n < 2; ++n) _Pragma("unroll") for (int k = 0; k < 2; ++k) dst[n][k] = *(const PG8_LAS bf16x8*)(lds + PG8_SB(b, h) + boff + n * 2048 + k * 1024); } while (0)
#define PG8_MMA(ai, bj, At, Bt) do { __builtin_amdgcn_s_setprio(1); _Pragma("unroll") for (int m = 0; m < 4; ++m) _Pragma("unroll") for (int n = 0; n < 2; ++n) _Pragma("unroll") for (int k = 0; k < 2; ++k) \
        acc[ai][bj][m][n] = __builtin_amdgcn_mfma_f32_16x16x32_bf16(Bt[n][k], At[m][k], acc[ai][bj][m][n], 0, 0, 0); __builtin_amdgcn_s_setprio(0); } while (0)
#define PG8_WAIT_V(n) asm volatile("s_waitcnt vmcnt(" #n ")" ::: "memory")
#define PG8_WAIT_L(n) asm volatile("s_waitcnt lgkmcnt(" #n ")" ::: "memory")
#define PG8_BAR __builtin_amdgcn_s_barrier()
#define PG8_SCHED __builtin_amdgcn_sched_barrier(0)
    Unit cur, nxt; int ui = 0;
    if (!S.next(0, cur)) return;
    f32x4 acc[2][2][4][2];
#pragma unroll
    for (int a = 0; a < 2; ++a)
#pragma unroll
        for (int b = 0; b < 2; ++b)
#pragma unroll
            for (int m = 0; m < 4; ++m)
#pragma unroll
                for (int n = 0; n < 2; ++n) acc[a][b][m][n] = (f32x4){0.f, 0.f, 0.f, 0.f};
    bf16x8 At[4][2], B0[2][2], B1[2][2];
    const char* cA = (const char*)g.A + (size_t)cur.pm * tstep; const char* cB = (const char*)g.Bt + (size_t)cur.pn * tstep;
    S.a_ready(cur);
    if constexpr (SP2) {
        PG8_STAGE(PG8_SB(0, 0), cB, voffB); PG8_STAGE(PG8_SB(0, 1), cB + hstep, voffB); PG8_STAGE(PG8_SA(0, 0), cA, voffA); PG8_STAGE(PG8_SA(0, 1), cA + hstep, voffA);
        if (wr == 1) PG8_BAR;
        PG8_WAIT_V(2); PG8_BAR;
        PG8_STAGE(PG8_SB(1, 0), cB + kstep, voffB); PG8_STAGE(PG8_SA(1, 0), cA + kstep, voffA); PG8_STAGE(PG8_SB(1, 1), cB + hstep + kstep, voffB);
        PG8_WAIT_V(6); PG8_BAR;
    } else {
        PG8_STAGE(PG8_SB(0, 0), cB, voffB); PG8_STAGE(PG8_SA(0, 0), cA, voffA); PG8_STAGE(PG8_SB(0, 1), cB + hstep, voffB); PG8_STAGE(PG8_SA(0, 1), cA + hstep, voffA);
        if (wr == 1) PG8_BAR;
        PG8_WAIT_V(4); PG8_BAR;
        PG8_STAGE(PG8_SB(1, 0), cB + kstep, voffB); PG8_STAGE(PG8_SA(1, 0), cA + kstep, voffA); PG8_STAGE(PG8_SB(1, 1), cB + hstep + kstep, voffB);
        PG8_WAIT_V(6); PG8_BAR;
    }
    for (;;) {
        const bool has_next = S.next(ui + 1, nxt);
        const char* nA = has_next ? (const char*)g.A + (size_t)nxt.pm * tstep : cA; const char* nB = has_next ? (const char*)g.Bt + (size_t)nxt.pn * tstep : cB;
        for (int t = 0; t < nt; t += 2) {
            const bool last = (t == nt - 2);
            const char* a1 = cA + (size_t)(t + 1) * kstep;
            const char* a2 = last ? nA : cA + (size_t)(t + 2) * kstep; const char* b2 = last ? nB : cB + (size_t)(t + 2) * kstep;
            const char* a3 = a2 + kstep; const char* b3 = b2 + kstep;
            if (last && has_next) S.a_ready(nxt);
            if constexpr (SP2) {
            PG8_LDB(B0, 0, 0); PG8_LDB(B1, 0, 1); PG8_SCHED; PG8_LDA(At, 0, 0); PG8_STAGE(PG8_SA(1, 1), a1 + hstep, voffA);
            PG8_WAIT_V(8); PG8_WAIT_L(0); PG8_BAR; PG8_MMA(0, 0, At, B0); PG8_MMA(0, 1, At, B1); PG8_BAR; PG8_SCHED;
            PG8_LDA(At, 0, 1); PG8_STAGE(PG8_SB(0, 0), b2, voffB); PG8_STAGE(PG8_SB(0, 1), b2 + hstep, voffB); PG8_STAGE(PG8_SA(0, 0), a2, voffA);
            PG8_WAIT_V(8); PG8_WAIT_L(0); PG8_BAR; PG8_MMA(1, 0, At, B0); PG8_MMA(1, 1, At, B1); PG8_BAR; PG8_SCHED;
            PG8_LDB(B0, 1, 0); PG8_LDB(B1, 1, 1); PG8_SCHED; PG8_LDA(At, 1, 0); PG8_STAGE(PG8_SA(0, 1), a2 + hstep, voffA);
            PG8_WAIT_V(8); PG8_WAIT_L(0); PG8_BAR; PG8_MMA(0, 0, At, B0); PG8_MMA(0, 1, At, B1); PG8_BAR; PG8_SCHED;
            PG8_LDA(At, 1, 1); PG8_STAGE(PG8_SB(1, 0), b3, voffB); PG8_STAGE(PG8_SB(1, 1), b3 + hstep, voffB); PG8_STAGE(PG8_SA(1, 0), a3, voffA);
            PG8_WAIT_V(8); PG8_WAIT_L(0); PG8_BAR; PG8_MMA(1, 0, At, B0); PG8_MMA(1, 1, At, B1); PG8_BAR; PG8_SCHED;
            } else {
            PG8_LDB(B0, 0, 0); PG8_SCHED; PG8_LDA(At, 0, 0); PG8_STAGE(PG8_SA(1, 1), a1 + hstep, voffA);
            PG8_WAIT_L(8); PG8_BAR; PG8_WAIT_L(0); PG8_MMA(0, 0, At, B0); PG8_BAR; PG8_SCHED;
            PG8_LDB(B1, 0, 1); PG8_STAGE(PG8_SB(0, 0), b2, voffB);
            PG8_BAR; PG8_WAIT_L(0); PG8_MMA(0, 1, At, B1); PG8_BAR;
            PG8_LDA(At, 0, 1); PG8_STAGE(PG8_SA(0, 0), a2, voffA);
            PG8_BAR; PG8_WAIT_L(0); PG8_MMA(1, 0, At, B0); PG8_BAR; PG8_SCHED;
            PG8_STAGE(PG8_SB(0, 1), b2 + hstep, voffB);
            PG8_WAIT_V(6); PG8_BAR; PG8_MMA(1, 1, At, B1); PG8_BAR;
            PG8_LDB(B0, 1, 0); PG8_SCHED; PG8_LDA(At, 1, 0); PG8_STAGE(PG8_SA(0, 1), a2 + hstep, voffA);
            PG8_WAIT_L(8); PG8_BAR; PG8_WAIT_L(0); PG8_MMA(0, 0, At, B0); PG8_BAR; PG8_SCHED;
            PG8_LDB(B1, 1, 1); PG8_STAGE(PG8_SB(1, 0), b3, voffB);
            PG8_BAR; PG8_WAIT_L(0); PG8_MMA(0, 1, At, B1); PG8_BAR;
            PG8_LDA(At, 1, 1); PG8_STAGE(PG8_SA(1, 0), a3, voffA);
            PG8_BAR; PG8_WAIT_L(0); PG8_MMA(1, 0, At, B0); PG8_BAR; PG8_SCHED;
            PG8_STAGE(PG8_SB(1, 1), b3 + hstep, voffB);
            PG8_WAIT_V(6); PG8_BAR; PG8_MMA(1, 1, At, B1); PG8_BAR;
            }
        }
        if constexpr (ALIGN_EPI) { if (wr == 0) PG8_BAR; }
        if constexpr (!Epi::AFTER_DRAIN) { E(acc, cur, wr, wc, fr, fq); S.done(cur); }
        if (!has_next) break;
#pragma unroll
        for (int a = 0; a < 2; ++a)
#pragma unroll
            for (int b = 0; b < 2; ++b)
#pragma unroll
                for (int m = 0; m < 4; ++m)
#pragma unroll
                    for (int n = 0; n < 2; ++n) acc[a][b][m][n] = (f32x4){0.f, 0.f, 0.f, 0.f};
        cur = nxt; cA = nA; cB = nB; ++ui;
        if constexpr (ALIGN_EPI) { if (wr == 1) PG8_BAR; }
    }
    PG8_WAIT_V(0);
    if constexpr (!ALIGN_EPI) { if (wr == 0) PG8_BAR; }
    PG8_BAR;
    if constexpr (Epi::AFTER_DRAIN) { E.fused(acc, cur, wr, wc, fr, fq, lds, wid, lane); S.done(cur); }
#undef PG8_SA
#undef PG8_SB
#undef PG8_STAGE
#undef PG8_LDA
#undef PG8_LDB
#undef PG8_MMA
#undef PG8_WAIT_V
#undef PG8_WAIT_L
#undef PG8_BAR
#undef PG8_SCHED
}
}

constexpr int DM = 1024, NB = 16, SEQ = 2048, MPR = NB * SEQ  , NS = 128  , MV = MPR + NS  , MPAD = 33024  ;
constexpr int ATT_IN = 4608, RET_IN = 6144, AW = 2048  , KVW = 256;
constexpr int PAST = 16384;
constexpr float EPS = 1e-6f;
constexpr float LOG2E = 1.4426950408889634f;
constexpr float C2 = 0.125f * LOG2E;
constexpr int NWAVES = 8, NTHR = 512;

constexpr size_t O_YP = 0, O_YS = 33554432, O_KP = 33685504, O_VP = 34209792, O_RP = 34734080, O_KS = 43122688, O_VS = 47316992, O_RS = 51511296, O_END = 118620160;

constexpr size_t MiB = 1u << 20;
constexpr size_t WS_WINA = 1 * MiB;
constexpr size_t WS_WOA  = 11 * MiB;
constexpr size_t WS_WINR = 16 * MiB;
constexpr size_t WS_WOR  = 29 * MiB;
constexpr size_t WS_COS  = 34 * MiB;
constexpr size_t WS_SIN  = 36 * MiB;
constexpr size_t WS_BT   = 38 * MiB;
constexpr size_t WS_SSQ1 = 39 * MiB;
constexpr size_t WS_STAT = 42 * MiB;
constexpr size_t WS_XN   = 60 * MiB;
constexpr size_t WS_Q    = 126 * MiB;
constexpr size_t WS_K    = 256 * MiB;
constexpr size_t WS_V    = 273 * MiB;
constexpr size_t WS_SG   = 290 * MiB;
constexpr size_t WS_OG   = 420 * MiB;
constexpr size_t WS_X1   = 550 * MiB;
constexpr size_t WS_ORAW = 680 * MiB;
constexpr size_t WS_END  = 810 * MiB;
static_assert(WS_WINA + (size_t)ATT_IN * DM * 2 <= WS_WOA && WS_WOA + (size_t)DM * AW * 2 <= WS_WINR && WS_WINR + (size_t)RET_IN * DM * 2 <= WS_WOR && WS_WOR + (size_t)DM * AW * 2 <= WS_COS, "ws map weights");
static_assert(WS_COS + 2049 * 128 * 4 <= WS_SIN && WS_SIN + 2049 * 128 * 4 <= WS_BT && WS_SSQ1 + (size_t)MPAD * 16 * 4 <= WS_STAT && WS_STAT + (size_t)MPAD * 4 * 16 * 2 * 4 <= WS_XN, "ws map tables");
static_assert(WS_XN + (size_t)MPAD * DM * 2 <= WS_Q && WS_Q + (size_t)MPAD * AW * 2 <= WS_K && WS_K + (size_t)MPAD * KVW * 2 <= WS_V && WS_V + (size_t)MPAD * KVW * 2 <= WS_SG, "ws map act 1");
static_assert(WS_SG + (size_t)MPAD * AW * 2 <= WS_OG && WS_OG + (size_t)MPAD * AW * 2 <= WS_X1 && WS_X1 + (size_t)MPAD * DM * 4 <= WS_ORAW && WS_ORAW + (size_t)MPAD * AW * 2 <= WS_END, "ws map act 2");

constexpr int LDS_BYTES = 147456;

#define GAS __attribute__((address_space(1)))
#define LAS __attribute__((address_space(3)))
typedef unsigned short bf16;
typedef unsigned v4u __attribute__((ext_vector_type(4)));
typedef unsigned v2u __attribute__((ext_vector_type(2)));
typedef float f32x4 __attribute__((ext_vector_type(4)));
typedef float f32x16 __attribute__((ext_vector_type(16)));
typedef short bf16x8 __attribute__((ext_vector_type(8)));
typedef short s16x4 __attribute__((ext_vector_type(4)));
#define LDS_WAIT() asm volatile("s_waitcnt lgkmcnt(0)" ::: "memory")
#define VM_WAIT() asm volatile("s_waitcnt vmcnt(0)" ::: "memory")

__device__ __forceinline__ unsigned f2bf(float f) { unsigned u = __builtin_bit_cast(unsigned, f); return (u + 0x7fffu + ((u >> 16) & 1u)) >> 16; }
typedef float f32x2_t __attribute__((ext_vector_type(2))); typedef __bf16 bf16x2_t __attribute__((ext_vector_type(2)));
__device__ __forceinline__ unsigned cvtpk(float lo, float hi) { f32x2_t v = {lo, hi}; bf16x2_t b = __builtin_convertvector(v, bf16x2_t); return __builtin_bit_cast(unsigned, b); }
__device__ __forceinline__ unsigned pk2(float lo, float hi) { return cvtpk(lo, hi); }
__device__ __forceinline__ float bf2f(unsigned short b) { return __builtin_bit_cast(float, (unsigned)b << 16); }
__device__ __forceinline__ float bflo(unsigned w) { return __builtin_bit_cast(float, w << 16); }
__device__ __forceinline__ float bfhi(unsigned w) { return __builtin_bit_cast(float, w & 0xffff0000u); }
__device__ __forceinline__ float silu_f(float x) { return x * __builtin_amdgcn_rcpf(1.0f + __expf(-x)); }
__device__ __forceinline__ float wave_sum(float v) {
#pragma unroll
    for (int o = 1; o < 64; o <<= 1) v += __shfl_xor(v, o);
    return v;
}
__device__ __forceinline__ float wave_max(float v) {
#pragma unroll
    for (int o = 1; o < 64; o <<= 1) v = fmaxf(v, __shfl_xor(v, o));
    return v;
}

struct Args { const float* in[13]; float* out; unsigned char* ws; int ph_lo, ph_hi; };

struct Frame {
    LAS unsigned char* lds;
    int wave, vcu, G;
    const float *xp, *xs, *ck, *cv, *st, *ng, *fg, *rb, *wia, *sk, *woa, *wir, *wor;
    float* out; unsigned char* ws;
};

__device__ __forceinline__ int lane_id() { int l; asm volatile("v_mbcnt_lo_u32_b32 %0, -1, 0\n\tv_mbcnt_hi_u32_b32 %0, -1, %0" : "=v"(l)); return l; }
__device__ __forceinline__ int cur_tid(const Frame& F) { return F.wave * 64 + lane_id(); }
__device__ __forceinline__ void p0_transpose_item(const float* W, int K, int N, bf16* WT, LAS float* scr, int item, int lane, const float* gk = nullptr) {
    const int nblk = N / 32, kb = item / nblk, nb = item % nblk, k0 = 64 * kb, n0 = 32 * nb;
#pragma unroll 16
    for (int i = 0; i < 32; ++i) { const int kk = 2 * i + (lane >> 5); const float gv = gk ? gk[k0 + kk] : 1.0f; scr[kk * 33 + (lane & 31)] = W[(size_t)(k0 + kk) * N + n0 + (lane & 31)] * gv; }
    LDS_WAIT(); asm volatile("" ::: "memory");
    const int c = lane & 7;
#pragma unroll
    for (int j = 0; j < 4; ++j) { const int n = (lane >> 3) + 8 * j; const LAS float* s = scr + (8 * c) * 33 + n;
        v4u o; o.x = pk2(s[0 * 33], s[1 * 33]); o.y = pk2(s[2 * 33], s[3 * 33]); o.z = pk2(s[4 * 33], s[5 * 33]); o.w = pk2(s[6 * 33], s[7 * 33]);
        *(GAS v4u*)(WT + (size_t)(n0 + n) * K + k0 + 8 * c) = o; }
    LDS_WAIT(); asm volatile("" ::: "memory");
}
__device__ __forceinline__ void rms_row_to_bf16(int lane, const float* xrow, const float* g, bf16* orow) {
    const GAS f32x4* xr = (const GAS f32x4*)xrow + lane; const GAS f32x4* gr = (const GAS f32x4*)g + lane;
    f32x4 v[4]; float s = 0.f;
#pragma unroll
    for (int j = 0; j < 4; ++j) { v[j] = xr[64 * j]; s += (v[j].x * v[j].x + v[j].y * v[j].y) + (v[j].z * v[j].z + v[j].w * v[j].w); }
    const float rstd = 1.0f / sqrtf(wave_sum(s) * (1.f / DM) + EPS);
    GAS unsigned long long* o8 = (GAS unsigned long long*)orow + lane;
#pragma unroll
    for (int j = 0; j < 4; ++j) { const f32x4 gg = gr[64 * j];
        o8[64 * j] = (unsigned long long)pk2(v[j].x * rstd * gg.x, v[j].y * rstd * gg.y) | ((unsigned long long)pk2(v[j].z * rstd * gg.z, v[j].w * rstd * gg.w) << 32); }
}
__device__ __forceinline__ int t5_bucket(int n) {
    if (n < 16) return n;
    int l = 16 + (int)(logf((float)n / 16.0f) / logf(8.0f) * 16.0f);
    return l < 31 ? l : 31;
}
__device__ __forceinline__ void p0_prologue(Frame& F) {
    LAS float* scr = (LAS float*)(F.lds + F.wave * 16384);
    const int gw = F.vcu * NWAVES + F.wave, NGW = F.G * NWAVES;
    bf16* WinA = (bf16*)(F.ws + WS_WINA); bf16* WoA = (bf16*)(F.ws + WS_WOA); bf16* WinR = (bf16*)(F.ws + WS_WINR); bf16* WoR = (bf16*)(F.ws + WS_WOR);
    constexpr int I_A = (DM / 64) * (ATT_IN / 32), I_B = (AW / 64) * (DM / 32), I_C = (DM / 64) * (RET_IN / 32), I_D = I_B;
    constexpr int NITEMS = I_A + I_B + I_C + I_D;
    for (int it = gw; it < NITEMS; it += NGW) {
        int r = it;
        if (r < I_A) { p0_transpose_item(F.wia, DM, ATT_IN, WinA, scr, r, lane_id()); continue; } r -= I_A;
        if (r < I_B) { p0_transpose_item(F.woa, AW, DM, WoA, scr, r, lane_id()); continue; } r -= I_B;
        if (r < I_C) { p0_transpose_item(F.wir, DM, RET_IN, WinR, scr, r, lane_id(), F.ng + DM); continue; } r -= I_C;
        p0_transpose_item(F.wor, AW, DM, WoR, scr, r, lane_id());
    }
    bf16* XN = (bf16*)(F.ws + WS_XN);
    {   const int lane = lane_id();
        for (int m = gw; m < MV; m += 2 * NGW) {
            const int m2 = m + NGW; const bool two = m2 < MV;
            const float* r0 = (m < MPR) ? F.xp + (size_t)m * DM : F.xs + (size_t)(m - MPR) * DM;
            const float* r1 = two ? ((m2 < MPR) ? F.xp + (size_t)m2 * DM : F.xs + (size_t)(m2 - MPR) * DM) : r0;
            const GAS f32x4* x0 = (const GAS f32x4*)r0 + lane; const GAS f32x4* x1 = (const GAS f32x4*)r1 + lane; const GAS f32x4* gr = (const GAS f32x4*)F.ng + lane;
            f32x4 a[4], b[4]; float sa = 0.f, sb = 0.f;
#pragma unroll
            for (int j = 0; j < 4; ++j) { a[j] = x0[64 * j]; b[j] = x1[64 * j]; }
#pragma unroll
            for (int j = 0; j < 4; ++j) { sa += (a[j].x * a[j].x + a[j].y * a[j].y) + (a[j].z * a[j].z + a[j].w * a[j].w); sb += (b[j].x * b[j].x + b[j].y * b[j].y) + (b[j].z * b[j].z + b[j].w * b[j].w); }
            const float ra = 1.0f / sqrtf(wave_sum(sa) * (1.f / DM) + EPS), rb = 1.0f / sqrtf(wave_sum(sb) * (1.f / DM) + EPS);
            GAS unsigned long long* o0 = (GAS unsigned long long*)(XN + (size_t)m * DM) + lane; GAS unsigned long long* o1 = (GAS unsigned long long*)(XN + (size_t)(two ? m2 : m) * DM) + lane;
#pragma unroll
            for (int j = 0; j < 4; ++j) { const f32x4 gg = gr[64 * j];
                o0[64 * j] = (unsigned long long)pk2(a[j].x * ra * gg.x, a[j].y * ra * gg.y) | ((unsigned long long)pk2(a[j].z * ra * gg.z, a[j].w * ra * gg.w) << 32);
                if (two) o1[64 * j] = (unsigned long long)pk2(b[j].x * rb * gg.x, b[j].y * rb * gg.y) | ((unsigned long long)pk2(b[j].z * rb * gg.z, b[j].w * rb * gg.w) << 32); }
        } }
    const int gt = F.vcu * NTHR + cur_tid(F), NGT = F.G * NTHR;
    float* COS = (float*)(F.ws + WS_COS); float* SIN = (float*)(F.ws + WS_SIN); float* BT = (float*)(F.ws + WS_BT);
    for (int i = gt; i < 2049 * 128; i += NGT) {
        const int p = i >> 7, f = i & 127; const double pos = (p == 2048) ? (double)PAST : (double)p;
        const double inv = exp(-(double)f * (9.210340371976184 / 128.0));
        const double ang = pos * inv;
        COS[i] = (float)cos(ang); SIN[i] = (float)sin(ang);
    }
    for (int i = gt; i < 32 * 128; i += NGT) { const int h = i >> 7, rel = i & 127; BT[i] = F.rb[t5_bucket(rel) * 32 + h] * LOG2E; }
    {   const GAS f32x4* ck = (const GAS f32x4*)F.ck; const GAS f32x4* cv = (const GAS f32x4*)F.cv;
        GAS f32x4* ok = (GAS f32x4*)(F.out + O_KS); GAS f32x4* ov = (GAS f32x4*)(F.out + O_VS);
        constexpr int NCP = NS * 127 * 64;
        for (int i0 = gt; i0 < NCP; i0 += 4 * NGT) { f32x4 kk[4], vv[4]; size_t dst[4];
#pragma unroll
            for (int j = 0; j < 4; ++j) { const int i = i0 + j * NGT, ic = i < NCP ? i : gt; const int s = ic / (127 * 64), r = ic - s * (127 * 64); dst[j] = (size_t)s * 8192 + r; kk[j] = ck[dst[j] + 64]; vv[j] = cv[dst[j] + 64]; }
#pragma unroll
            for (int j = 0; j < 4; ++j) if (i0 + j * NGT < NCP) { ok[dst[j]] = kk[j]; ov[dst[j]] = vv[j]; } } }
}

struct EpiAttnIn {
    static constexpr bool PERM = true, AFTER_DRAIN = false;
    bf16 *Q, *K, *V, *SG; float* out;
    __device__ __forceinline__ void operator()(const pg8::f32x4 (&acc)[2][2][4][2], const pg8::Unit& u, int wr, int wc, int fr, int fq) const {
        const int pn = u.pn, row0 = u.pm * 256 + wr * 64 + fr, cl0 = wc * 32 + 8 * fq;
#pragma unroll
        for (int ai = 0; ai < 2; ++ai)
#pragma unroll
            for (int m = 0; m < 4; ++m) { const int row = row0 + ai * 128 + m * 16;
#pragma unroll
                for (int bj = 0; bj < 2; ++bj) { const int cl = cl0 + bj * 128; pg8::f32x4 v0 = acc[ai][bj][m][0], v1 = acc[ai][bj][m][1];
                    if (pn < 8) { v0 = v0 * C2; v1 = v1 * C2; v4u w; w.x = pk2(v0[0], v0[1]); w.y = pk2(v0[2], v0[3]); w.z = pk2(v1[0], v1[1]); w.w = pk2(v1[2], v1[3]);
                        *(GAS v4u*)(Q + (size_t)row * AW + pn * 256 + cl) = w; }
                    else if (pn < 10) { v4u w; w.x = pk2(v0[0], v0[1]); w.y = pk2(v0[2], v0[3]); w.z = pk2(v1[0], v1[1]); w.w = pk2(v1[2], v1[3]);
                        bf16* dst = (pn == 8) ? K : V; *(GAS v4u*)(dst + (size_t)row * KVW + cl) = w;
                        float* o = nullptr;
                        if (row < MPR) { const int b = row >> 11, t = row & 2047; if (t >= SEQ - 128) o = out + (pn == 8 ? O_KP : O_VP) + (size_t)(b * 128 + t - (SEQ - 128)) * 256 + cl; }
                        else if (row < MV) { o = out + (pn == 8 ? O_KS : O_VS) + (size_t)((row - MPR) * 128 + 127) * 256 + cl; }
                        if (o) { *(GAS f32x4*)o = v0; *(GAS f32x4*)(o + 4) = v1; } }
                    else { v4u w; w.x = pk2(silu_f(v0[0]), silu_f(v0[1])); w.y = pk2(silu_f(v0[2]), silu_f(v0[3])); w.z = pk2(silu_f(v1[0]), silu_f(v1[1])); w.w = pk2(silu_f(v1[2]), silu_f(v1[3]));
                        *(GAS v4u*)(SG + (size_t)row * AW + (pn - 10) * 256 + cl) = w; } } }
    }
};

struct EpiOutRes {
    static constexpr bool PERM = false, AFTER_DRAIN = false;
    const float* xp; bf16* XN2; float* ssq;
    __device__ __forceinline__ void operator()(const pg8::f32x4 (&acc)[2][2][4][2], const pg8::Unit& u, int wr, int wc, int fr, int fq) const {
        const int row0 = u.pm * 256 + wr * 64 + fr, c0 = u.pn * 256 + wc * 32 + 4 * fq;
#pragma unroll
        for (int ai = 0; ai < 2; ++ai) {
            f32x4 x[4][2][2];
#pragma unroll
            for (int m = 0; m < 4; ++m)
#pragma unroll
                for (int bj = 0; bj < 2; ++bj)
#pragma unroll
                    for (int n = 0; n < 2; ++n) x[m][bj][n] = *(const GAS f32x4*)(xp + (size_t)(row0 + ai * 128 + m * 16) * DM + c0 + bj * 128 + n * 16);
#pragma unroll
            for (int m = 0; m < 4; ++m) { const int row = row0 + ai * 128 + m * 16; float sq = 0.f;
#pragma unroll
                for (int bj = 0; bj < 2; ++bj)
#pragma unroll
                    for (int n = 0; n < 2; ++n) { const int col = c0 + bj * 128 + n * 16; const f32x4 v = x[m][bj][n] + acc[ai][bj][m][n];
                        v2u w; w.x = pk2(v[0], v[1]); w.y = pk2(v[2], v[3]); *(GAS v2u*)(XN2 + (size_t)row * DM + col) = w;
                        sq += (v[0] * v[0] + v[1] * v[1]) + (v[2] * v[2] + v[3] * v[3]); }
                sq += __shfl_xor(sq, 16); sq += __shfl_xor(sq, 32);
                if (fq == 0) ssq[(size_t)row * 16 + u.pn * 4 + wc] = sq; } }
    }
};
struct EpiOutFinal {
    static constexpr bool PERM = false, AFTER_DRAIN = false;
    const bf16* X1b; float* out;
    __device__ __forceinline__ void operator()(const pg8::f32x4 (&acc)[2][2][4][2], const pg8::Unit& u, int wr, int wc, int fr, int fq) const {
        const int row0 = u.pm * 256 + wr * 64 + fr, c0 = u.pn * 256 + wc * 32 + 4 * fq;
        v2u xw[2][4][2][2];
#pragma unroll
        for (int ai = 0; ai < 2; ++ai)
#pragma unroll
            for (int m = 0; m < 4; ++m)
#pragma unroll
                for (int bj = 0; bj < 2; ++bj)
#pragma unroll
                    for (int n = 0; n < 2; ++n) xw[ai][m][bj][n] = *(const GAS v2u*)(X1b + (size_t)(row0 + ai * 128 + m * 16) * DM + c0 + bj * 128 + n * 16);
#pragma unroll
        for (int ai = 0; ai < 2; ++ai)
#pragma unroll
            for (int m = 0; m < 4; ++m) { float* orow = out + O_YP + (size_t)(row0 + ai * 128 + m * 16) * DM;
#pragma unroll
                for (int bj = 0; bj < 2; ++bj)
#pragma unroll
                    for (int n = 0; n < 2; ++n) { const v2u w = xw[ai][m][bj][n]; const f32x4 x = {bflo(w.x), bfhi(w.x), bflo(w.y), bfhi(w.y)};
                        *(GAS f32x4*)(orow + c0 + bj * 128 + n * 16) = x + acc[ai][bj][m][n]; } }
    }
};
struct EpiRetIn {
    static constexpr bool PERM = true, AFTER_DRAIN = false;
    const float *ssq, *COS, *SIN; bf16 *Qr, *Kr, *Vr, *SG2;
    __device__ __forceinline__ void operator()(const pg8::f32x4 (&acc)[2][2][4][2], const pg8::Unit& u, int wr, int wc, int fr, int fq) const {
        const int pn = u.pn, row0 = u.pm * 256 + wr * 64 + fr, cl0 = wc * 32 + 8 * fq;
        float rs[2][4];
        {   f32x4 t[2][4];
#pragma unroll
            for (int ai = 0; ai < 2; ++ai)
#pragma unroll
                for (int m = 0; m < 4; ++m) t[ai][m] = *(const GAS f32x4*)(ssq + (size_t)(row0 + ai * 128 + m * 16) * 16 + 4 * fq);
#pragma unroll
            for (int ai = 0; ai < 2; ++ai)
#pragma unroll
                for (int m = 0; m < 4; ++m) { float s = (t[ai][m][0] + t[ai][m][1]) + (t[ai][m][2] + t[ai][m][3]); s += __shfl_xor(s, 16); s += __shfl_xor(s, 32);
                    rs[ai][m] = 1.0f / sqrtf(s * (1.f / DM) + EPS); } }
        if (pn < 8) {
            const float lgh = __builtin_amdgcn_logf(1.0f - __builtin_amdgcn_exp2f(-5.0f - (float)(pn & 3)));
            bf16* dstb = ((pn < 4) ? Qr : Kr) + (pn & 3) * 256 + cl0;
#pragma unroll
            for (int aim = 0; aim < 4; ++aim) { const int ai = aim >> 1;
                f32x4 cc[4][2], ss[4][2];
#pragma unroll
                for (int m = 2 * (aim & 1); m < 2 * (aim & 1) + 2; ++m) { const int p = (row0 + ai * 128 + m * 16) & 2047;
#pragma unroll
                    for (int n = 0; n < 2; ++n) { cc[m][n] = *(const GAS f32x4*)(COS + p * 128 + cl0 + 4 * n); ss[m][n] = *(const GAS f32x4*)(SIN + p * 128 + cl0 + 4 * n); } }
#pragma unroll
                for (int m = 2 * (aim & 1); m < 2 * (aim & 1) + 2; ++m) { const int row = row0 + ai * 128 + m * 16;
                    const float lg = lgh * (float)(row & 63);
                    const float sc = (pn < 4) ? rs[ai][m] * __builtin_amdgcn_exp2f(lg) : rs[ai][m] * 0.0625f * __builtin_amdgcn_exp2f(-lg);
                    v4u w1, w2;
#pragma unroll
                    for (int n = 0; n < 2; ++n) { const f32x4 x1 = acc[ai][0][m][n] * sc, x2 = acc[ai][1][m][n] * sc;
                        const f32x4 o1 = x1 * cc[m][n] - x2 * ss[m][n], o2 = x1 * ss[m][n] + x2 * cc[m][n];
                        if (n == 0) { w1.x = pk2(o1[0], o1[1]); w1.y = pk2(o1[2], o1[3]); w2.x = pk2(o2[0], o2[1]); w2.y = pk2(o2[2], o2[3]); }
                        else { w1.z = pk2(o1[0], o1[1]); w1.w = pk2(o1[2], o1[3]); w2.z = pk2(o2[0], o2[1]); w2.w = pk2(o2[2], o2[3]); } }
                    bf16* dst = dstb + (size_t)row * DM; *(GAS v4u*)dst = w1; *(GAS v4u*)(dst + 128) = w2; } }
        } else if (pn < 16) {
#pragma unroll
            for (int ai = 0; ai < 2; ++ai)
#pragma unroll
                for (int m = 0; m < 4; ++m) { const int row = row0 + ai * 128 + m * 16; const float rstd = rs[ai][m];
#pragma unroll
                    for (int bj = 0; bj < 2; ++bj) { const int cl = cl0 + bj * 128; const pg8::f32x4 v0 = acc[ai][bj][m][0] * rstd, v1 = acc[ai][bj][m][1] * rstd; v4u w;
                        w.x = pk2(v0[0], v0[1]); w.y = pk2(v0[2], v0[3]); w.z = pk2(v1[0], v1[1]); w.w = pk2(v1[2], v1[3]);
                        *(GAS v4u*)(Vr + (size_t)row * AW + (pn - 8) * 256 + cl) = w; } }
        } else {
#pragma unroll
            for (int ai = 0; ai < 2; ++ai)
#pragma unroll
                for (int m = 0; m < 4; ++m) { const int row = row0 + ai * 128 + m * 16; const float rstd = rs[ai][m];
#pragma unroll
                    for (int bj = 0; bj < 2; ++bj) { const int cl = cl0 + bj * 128; const pg8::f32x4 v0 = acc[ai][bj][m][0] * rstd, v1 = acc[ai][bj][m][1] * rstd; v4u w;
                        w.x = pk2(silu_f(v0[0]), silu_f(v0[1])); w.y = pk2(silu_f(v0[2]), silu_f(v0[3])); w.z = pk2(silu_f(v1[0]), silu_f(v1[1])); w.w = pk2(silu_f(v1[2]), silu_f(v1[3]));
                        *(GAS v4u*)(SG2 + (size_t)row * AW + (pn - 16) * 256 + cl) = w; } }
        }
    }
};

#define MFMA32(a, b, c) __builtin_amdgcn_mfma_f32_32x32x16_bf16((a), (b), (c), 0, 0, 0)
#define MFMA16(a, b, c) __builtin_amdgcn_mfma_f32_16x16x32_bf16((a), (b), (c), 0, 0, 0)
typedef short v4i16_t __attribute__((ext_vector_type(4)));
__device__ __forceinline__ int crow(int r, int hi) { return (r & 3) + 8 * (r >> 2) + 4 * hi; }
__device__ __forceinline__ s16x4 vtr(const LAS unsigned char* p) { return __builtin_bit_cast(s16x4, __builtin_amdgcn_ds_read_tr16_b64_v4i16((LAS v4i16_t*)p)); }
__device__ __forceinline__ bf16x8 pack8(const f32x16& x, int s) {
    v4u p; p.x = cvtpk(x[8 * s], x[8 * s + 1]); p.y = cvtpk(x[8 * s + 2], x[8 * s + 3]); p.z = cvtpk(x[8 * s + 4], x[8 * s + 5]); p.w = cvtpk(x[8 * s + 6], x[8 * s + 7]);
    return __builtin_bit_cast(bf16x8, p);
}
__device__ __forceinline__ bf16x8 cat44(s16x4 lo, s16x4 hi) { return (bf16x8){lo[0], lo[1], lo[2], lo[3], hi[0], hi[1], hi[2], hi[3]}; }
__device__ __forceinline__ float half_swap_max(float m) { auto rr = __builtin_amdgcn_permlane32_swap(__float_as_uint(m), __float_as_uint(m), false, false); return fmaxf(__uint_as_float(rr[0]), __uint_as_float(rr[1])); }
__device__ __forceinline__ float half_swap_sum(float m) { auto rr = __builtin_amdgcn_permlane32_swap(__float_as_uint(m), __float_as_uint(m), false, false); return __uint_as_float(rr[0]) + __uint_as_float(rr[1]); }

constexpr int AT_KSTR = 2064, AT_VDH = 8256, AT_BLK = 8 * AT_KSTR + 2 * AT_VDH  , AT_VOFF = 8 * AT_KSTR;
constexpr int AT_RING = 0, AT_BT = 3 * AT_BLK  , AT_BTW = 800, AT_WS = AT_BT + 8 * AT_BTW  , AT_OST = AT_WS + 2048  , AT_END = AT_OST + 8 * 4096;
static_assert(AT_END <= LDS_BYTES, "attention LDS");
constexpr float NEGBIG = -1.0e30f;

__device__ __forceinline__ void attn_dma_block(Frame& F, int gid, int lane) {
    const bf16* Kb = (const bf16*)(F.ws + WS_K); const bf16* Vb = (const bf16*)(F.ws + WS_V);
    const int bk = gid >> 4, kvh = bk & 3, b = bk >> 2, qb = gid & 15; const size_t row0 = (size_t)b * SEQ + qb * 128;
    LAS unsigned char* blk = F.lds + AT_RING + (gid % 3) * AT_BLK; const int w = F.wave;
#pragma unroll
    for (int i = 0; i < 2; ++i) {
        __builtin_amdgcn_global_load_lds((const GAS unsigned*)(Kb + (row0 + 64 * i + lane) * KVW + kvh * 64 + w * 8), (LAS unsigned*)(blk + w * AT_KSTR + i * 1024), 16, 0, 0);
        const int p = 2 * w + i, dh = p >> 3, kg = p & 7;
        __builtin_amdgcn_global_load_lds((const GAS unsigned*)(Vb + (row0 + 16 * kg + (lane >> 2)) * KVW + kvh * 64 + dh * 32 + (lane & 3) * 8), (LAS unsigned*)(blk + AT_VOFF + dh * AT_VDH + kg * 1024), 16, 0, 0); }
}
__device__ __forceinline__ void attn_prompt_unit(Frame& F, int gid, int lane) {
    const int r32 = lane & 31, hi = lane >> 5, wid = F.wave;
    const bf16* Qb = (const bf16*)(F.ws + WS_Q); const bf16* SG = (const bf16*)(F.ws + WS_SG); bf16* OG = (bf16*)(F.ws + WS_OG);
    const int bk = gid >> 4, kvh = bk & 3, b = bk >> 2, qb = gid & 15;
    const int head = kvh * 8 + wid; const size_t rowbase = (size_t)b * SEQ; const int t0 = qb * 128;
    LAS unsigned char* lds = F.lds;
    const unsigned tboff = (unsigned)AT_BT + (unsigned)(wid & 7) * AT_BTW + (((unsigned)lane & 31u) + 4u * (1u - (((unsigned)lane >> 5) & 1u))) * 4u;
    LAS float* wsf = (LAS float*)(lds + AT_WS) + wid * 64;
    LAS unsigned short* stg = (LAS unsigned short*)(lds + AT_OST + wid * 4096);
    const float sinkv = F.sk[head] * LOG2E;
    const int slotc = (gid % 3) * AT_BLK, slotp = ((gid + 2) % 3) * AT_BLK;
    const int vlane = (4 * hi + ((lane & 15) >> 2)) * 64 + ((lane >> 4) & 1) * 32 + (lane & 3) * 8;
    const int ktmin = (qb == 0) ? 4 : 0;
    const bf16* Qw = Qb + (rowbase + t0 + r32) * AW + head * 64 + hi * 8;
    bf16x8 qr[4];
#pragma unroll
    for (int d0 = 0; d0 < 4; ++d0) qr[d0] = *(const GAS bf16x8*)(Qw + d0 * 16);
    for (int qt = 0; qt < 4; ++qt) {
        f32x16 p[5];
        float mx0 = sinkv, mx1 = sinkv, mx2 = sinkv, mx3 = sinkv;
        unsigned tbo = tboff; asm volatile("" : "+v"(tbo));
#pragma unroll
        for (int j = 0; j < 5; ++j) { const int kt = qt + j;
            f32x16 a;
#pragma unroll
            for (int r = 0; r < 16; ++r) a[r] = *(const LAS float*)(lds + tbo + 4 * (159 - 32 * j - ((r & 3) + 8 * (r >> 2))));
            if (kt >= ktmin) {
                const LAS unsigned char* kb = lds + ((kt >> 2) ? slotc : slotp) + hi * AT_KSTR + ((kt & 3) * 32 + r32) * 16;
#pragma unroll
                for (int d0 = 0; d0 < 4; ++d0) { const bf16x8 kf = *(const LAS bf16x8*)(kb + 2 * d0 * AT_KSTR); a = MFMA32(kf, qr[d0], a); }
            } else {
#pragma unroll
                for (int r = 0; r < 16; ++r) a[r] = NEGBIG;
            }
#pragma unroll
            for (int r = 0; r < 16; r += 4) { mx0 = fmaxf(mx0, a[r]); mx1 = fmaxf(mx1, a[r + 1]); mx2 = fmaxf(mx2, a[r + 2]); mx3 = fmaxf(mx3, a[r + 3]); }
            p[j] = a; }
        asm volatile("" ::: "memory");
        if (qt < 3) {
#pragma unroll
            for (int d0 = 0; d0 < 4; ++d0) qr[d0] = *(const GAS bf16x8*)(Qw + (size_t)(qt + 1) * 32 * AW + d0 * 16); }
        v4u gv[4];
#pragma unroll
        for (int i = 0; i < 4; ++i) gv[i] = *(const GAS v4u*)(SG + (rowbase + t0 + qt * 32 + i * 8 + (lane >> 3)) * AW + head * 64 + (lane & 7) * 8);
        asm volatile("" ::: "memory");
        const float mx = half_swap_max(fmaxf(fmaxf(mx0, mx1), fmaxf(mx2, mx3)));
        float l0 = 0.f, l1 = 0.f, l2 = 0.f, l3 = 0.f;
        bf16x8 pa[5][2];
#pragma unroll
        for (int j = 0; j < 5; ++j) {
#pragma unroll
            for (int r = 0; r < 16; r += 4) { const float e0 = __builtin_amdgcn_exp2f(p[j][r] - mx), e1 = __builtin_amdgcn_exp2f(p[j][r + 1] - mx), e2 = __builtin_amdgcn_exp2f(p[j][r + 2] - mx), e3 = __builtin_amdgcn_exp2f(p[j][r + 3] - mx);
                p[j][r] = e0; p[j][r + 1] = e1; p[j][r + 2] = e2; p[j][r + 3] = e3; l0 += e0; l1 += e1; l2 += e2; l3 += e3; }
            pa[j][0] = pack8(p[j], 0); pa[j][1] = pack8(p[j], 1); }
        const float l = half_swap_sum((l0 + l1) + (l2 + l3)) + __builtin_amdgcn_exp2f(sinkv - mx);
        f32x16 o[2]; o[0] = f32x16{}; o[1] = f32x16{};
#pragma unroll
        for (int j = 0; j < 5; ++j) { const int kt = qt + j;
            if (kt >= ktmin) {
                const LAS unsigned char* vb = lds + ((kt >> 2) ? slotc : slotp) + AT_VOFF + (kt & 3) * 2048 + vlane;
#pragma unroll
                for (int s = 0; s < 2; ++s) {
#pragma unroll
                    for (int d0 = 0; d0 < 2; ++d0) { const LAS unsigned char* vp = vb + d0 * AT_VDH + s * 1024;
                        const s16x4 lo = vtr(vp), hh = vtr(vp + 512); o[d0] = MFMA32(pa[j][s], cat44(lo, hh), o[d0]); } } } }
        if (hi == 0) wsf[32 + r32] = l;
        LDS_WAIT(); asm volatile("" ::: "memory");
#pragma unroll
        for (int r = 0; r < 16; ++r) { const int orow = crow(r, hi); const float rl = __builtin_amdgcn_rcpf(wsf[32 + orow]);
            stg[orow * 64 + r32] = (unsigned short)f2bf(o[0][r] * rl); stg[orow * 64 + 32 + r32] = (unsigned short)f2bf(o[1][r] * rl); }
        LDS_WAIT(); asm volatile("" ::: "memory");
#pragma unroll
        for (int i = 0; i < 4; ++i) { const int row = i * 8 + (lane >> 3), ch = lane & 7; const v4u ov = *(const LAS v4u*)(stg + row * 64 + ch * 8);
            const size_t gi = (rowbase + t0 + qt * 32 + row) * AW + head * 64 + ch * 8; v4u w;
            w.x = pk2(bflo(ov.x) * bflo(gv[i].x), bfhi(ov.x) * bfhi(gv[i].x)); w.y = pk2(bflo(ov.y) * bflo(gv[i].y), bfhi(ov.y) * bfhi(gv[i].y));
            w.z = pk2(bflo(ov.z) * bflo(gv[i].z), bfhi(ov.z) * bfhi(gv[i].z)); w.w = pk2(bflo(ov.w) * bflo(gv[i].w), bfhi(ov.w) * bfhi(gv[i].w));
            *(GAS v4u*)(OG + gi) = w; }
        LDS_WAIT(); asm volatile("" ::: "memory");
    }
}
__device__ __forceinline__ void p2_prompt_attention(Frame& F) {
    const int lane = lane_id();
    const int per = (1024 + F.G - 1) / F.G, u0 = F.vcu * per, u1 = (u0 + per < 1024) ? u0 + per : 1024;
    if (u0 >= u1) return;
    const float* BT = (const float*)(F.ws + WS_BT);
    if ((u0 & 15) != 0) attn_dma_block(F, u0 - 1, lane);
    attn_dma_block(F, u0, lane);
    int head_cur = -1;
    for (int u = u0; u < u1; ++u) {
        const int head = ((u >> 4) & 3) * 8 + F.wave;
        if (head != head_cur) { head_cur = head; LAS float* tbw = (LAS float*)(F.lds + AT_BT + F.wave * AT_BTW);
#pragma unroll
            for (int i = 0; i < 4; ++i) { const int k = lane + 64 * i, rel = k - 35; if (k < 200) tbw[k] = (rel >= 0 && rel < 128) ? BT[head * 128 + rel] : NEGBIG; } }
        asm volatile("s_waitcnt vmcnt(0) lgkmcnt(0)" ::: "memory"); __syncthreads();
        if (u + 1 < u1) attn_dma_block(F, u + 1, lane);
        attn_prompt_unit(F, u, lane);
    }
    asm volatile("s_waitcnt vmcnt(0) lgkmcnt(0)" ::: "memory"); __syncthreads();
}

constexpr int AS_K = 0, AS_V = 33280, AS_Q = 66048, AS_P = 68096;
__device__ __forceinline__ void attn_sample_unit(Frame& F, int s, int kvh) {
    const int tid = cur_tid(F), lane = lane_id(), wid = F.wave;
    LAS float* Kf = (LAS float*)(F.lds + AS_K); LAS float* Vf = (LAS float*)(F.lds + AS_V); LAS float* qf = (LAS float*)(F.lds + AS_Q) + wid * 64; LAS float* pb = (LAS float*)(F.lds + AS_P) + wid * 128;
    const bf16* Qb = (const bf16*)(F.ws + WS_Q); const bf16* SG = (const bf16*)(F.ws + WS_SG); bf16* OG = (bf16*)(F.ws + WS_OG); const float* BT = (const float*)(F.ws + WS_BT);
    const int head = kvh * 8 + wid; const size_t row = (size_t)MPR + s;
#pragma unroll
    for (int i = 0; i < 4; ++i) { const int idx = tid + 512 * i, jj = idx >> 4, c4 = idx & 15;
        const float* ksrc = (jj < 127) ? F.ck + ((size_t)(s * 128 + jj + 1) * 4 + kvh) * 64 : F.out + O_KS + ((size_t)(s * 128 + 127) * 4 + kvh) * 64;
        const float* vsrc = (jj < 127) ? F.cv + ((size_t)(s * 128 + jj + 1) * 4 + kvh) * 64 : F.out + O_VS + ((size_t)(s * 128 + 127) * 4 + kvh) * 64;
        const f32x4 kv = *(const GAS f32x4*)(ksrc + c4 * 4), vv = *(const GAS f32x4*)(vsrc + c4 * 4);
        Kf[jj * 65 + c4 * 4 + 0] = kv[0]; Kf[jj * 65 + c4 * 4 + 1] = kv[1]; Kf[jj * 65 + c4 * 4 + 2] = kv[2]; Kf[jj * 65 + c4 * 4 + 3] = kv[3];
        *(LAS f32x4*)(Vf + jj * 64 + c4 * 4) = vv; }
    qf[lane] = bf2f(Qb[row * AW + head * 64 + lane]);
    __syncthreads();
    float s0 = 0.f, s1 = 0.f;
#pragma unroll 8
    for (int d = 0; d < 64; ++d) { const float q = qf[d]; s0 += q * Kf[lane * 65 + d]; s1 += q * Kf[(lane + 64) * 65 + d]; }
    s0 += BT[head * 128 + 127 - lane]; s1 += BT[head * 128 + 63 - lane];
    const float sinkv = F.sk[head] * LOG2E;
    const float mx = fmaxf(wave_max(fmaxf(s0, s1)), sinkv);
    const float p0 = __builtin_amdgcn_exp2f(s0 - mx), p1 = __builtin_amdgcn_exp2f(s1 - mx);
    const float l = wave_sum(p0 + p1) + __builtin_amdgcn_exp2f(sinkv - mx);
    pb[lane] = p0; pb[lane + 64] = p1;
    LDS_WAIT(); asm volatile("" ::: "memory");
    float o = 0.f;
#pragma unroll 8
    for (int jj = 0; jj < 128; ++jj) o += pb[jj] * Vf[jj * 64 + lane];
    const size_t gi = row * AW + head * 64 + lane;
    OG[gi] = (unsigned short)f2bf(o / l * bf2f(SG[gi]));
    __syncthreads();
}
__device__ __forceinline__ void p2_attention(Frame& F) {
    p2_prompt_attention(F);
#ifndef DUP_AS
#define DUP_AS 1
#endif
    for (int rep = 0; rep < DUP_AS; ++rep)
    for (int u = F.vcu; u < NS * 4; u += F.G) attn_sample_unit(F, u >> 2, u & 3);
}

__device__ __forceinline__ unsigned off_a(unsigned row, unsigned ch) { return 2048u * (row >> 3) + 512u * (ch >> 2) + 64u * (row & 7) + 16u * ((ch & 3) ^ ((row >> 2) & 3)); }
__device__ __forceinline__ unsigned tr_base(unsigned lane, unsigned t) {
    const unsigned h = lane >> 5, blk = (lane >> 4) & 1, q = (lane & 15) >> 2, p = lane & 3;
    return 2048u * h + 64u * (4 * t + q) + 16u * ((2 * blk + (p >> 1)) ^ (2 * h + t)) + 8u * (p & 1);
}
constexpr int RT_QS = 528;
constexpr int RT_Q = 0, RT_K = 33792, RT_V = 66560, RT_P = 82944, RT_X = 92160, RT_O = 124928, RT_END = 141312;
constexpr int RT_PS = 144;
static_assert(RT_END <= LDS_BYTES, "retention LDS");
constexpr int RC = 64;

__device__ __forceinline__ void ret_sample_unit(Frame& F, int s, int h);
__device__ __forceinline__ void ret_prompt_unit(Frame& F, int b, int h, int es, int su0, int ss0, int su1, int ss1) {
    int tid_ = cur_tid(F); asm volatile("" : "+v"(tid_));
    const int tid = tid_, lane = tid & 63, r32 = lane & 31, hi = lane >> 5, wid = F.wave, ec = wid & 3, dh = wid >> 2;
    LAS unsigned char* lds = F.lds;
    const bf16* Qr = (const bf16*)(F.ws + WS_Q); const bf16* Kr = Qr + (size_t)MPAD * DM; const bf16* Vr = (const bf16*)(F.ws + WS_SG);
    bf16* ORAW = (bf16*)(F.ws + WS_ORAW); float* STAT = (float*)(F.ws + WS_STAT);
    const size_t rowbase = (size_t)b * SEQ;
    const float gam = 1.0f - exp2f(-5.0f - (float)h);
    const float gCm1 = exp2f(log2f(gam) * (float)(RC - 1));
    f32x16 R[4];
#pragma unroll
    for (int dt = 0; dt < 4; ++dt) R[dt] = f32x16{};
    v4u sq[4], sk[4], sv[2];
    const int qrow = tid >> 5, qch = tid & 31;
    const int vrow = tid >> 4, vch = tid & 15;
#define RT_LOAD(step) do { const size_t tok0_ = rowbase + (size_t)(step) * RC; \
    _Pragma("unroll") for (int i_ = 0; i_ < 4; ++i_) { const size_t g_ = (tok0_ + qrow + 16 * i_) * DM + h * 256 + qch * 8; sq[i_] = *(const GAS v4u*)(Qr + g_); sk[i_] = *(const GAS v4u*)(Kr + g_); } \
    _Pragma("unroll") for (int i_ = 0; i_ < 2; ++i_) sv[i_] = *(const GAS v4u*)(Vr + (tok0_ + vrow + 32 * i_) * AW + h * 512 + es * 128 + vch * 8); } while (0)
#define RT_WRITE() do { \
    _Pragma("unroll") for (int i_ = 0; i_ < 4; ++i_) { const int row_ = qrow + 16 * i_; *(LAS v4u*)(lds + RT_Q + row_ * RT_QS + qch * 16) = sq[i_]; \
        *(LAS v4u*)(lds + RT_K + (qch >> 4) * 16384 + off_a(row_, qch & 15)) = sk[i_]; } \
    _Pragma("unroll") for (int i_ = 0; i_ < 2; ++i_) { const int row_ = vrow + 32 * i_; *(LAS v4u*)(lds + RT_V + off_a(row_, vch)) = sv[i_]; } } while (0)
#define RT_FLUSH(stp) do { LAS unsigned short* stg = (LAS unsigned short*)(lds + RT_O + wid * 2048); \
            const int orow = lane >> 1, half = lane & 1; \
            const v4u a0 = *(const LAS v4u*)(stg + orow * 32 + half * 16), a1 = *(const LAS v4u*)(stg + orow * 32 + half * 16 + 8); \
            float sm = 0.f, s2m = 0.f; \
            RT_ACC(a0.x); RT_ACC(a0.y); RT_ACC(a0.z); RT_ACC(a0.w); RT_ACC(a1.x); RT_ACC(a1.y); RT_ACC(a1.z); RT_ACC(a1.w); \
            sm += __shfl_xor(sm, 1); s2m += __shfl_xor(s2m, 1); \
            const size_t grow = rowbase + (size_t)(stp) * RC + 32 * dh + orow; \
            bf16* op = ORAW + grow * AW + h * 512 + es * 128 + ec * 32 + half * 16; \
            *(GAS v4u*)op = a0; *(GAS v4u*)(op + 8) = a1; \
            STAT[((grow * 4 + h) * 16 + es * 4 + ec) * 2 + half] = half ? s2m : sm; } while (0)
#define RT_ACC(w) do { const float x0_ = bflo(w), x1_ = bfhi(w); sm += x0_ + x1_; s2m += x0_ * x0_ + x1_ * x1_; } while (0)
    RT_LOAD(0);
    const int NSTEP = SEQ / RC;
    for (int step = 0; step < NSTEP; ++step) {
        RT_WRITE();
        __syncthreads();
        if (step > 0) RT_FLUSH(step - 1);
        RT_LOAD((step + 1 < NSTEP) ? step + 1 : step);
        const unsigned k16 = 2048u * ((lane & 15) >> 3) + 64u * (lane & 7) + 16u * ((lane >> 4) ^ (((lane & 15) >> 2) & 3));
#pragma unroll
        for (int tt = 0; tt < 2; ++tt) { const int T = 2 * wid + tt, jt = T >> 2, it = T & 3; const int l15 = lane & 15, g = lane >> 4;
            f32x4 a = {0.f, 0.f, 0.f, 0.f};
            if (jt <= it) {
#pragma unroll
                for (int s = 0; s < 8; ++s) {
                    const bf16x8 ka = *(const LAS bf16x8*)(lds + RT_K + k16 + 4096 * jt + (s >> 2) * 16384 + 512 * (s & 3));
                    const bf16x8 qb = *(const LAS bf16x8*)(lds + RT_Q + (16 * it + l15) * RT_QS + (32 * s + 8 * g) * 2);
                    a = MFMA16(ka, qb, a); }
            }
            const int i = 16 * it + l15, j0 = 16 * jt + 4 * g;
            v2u w; w.x = pk2((i >= j0) ? a[0] : 0.f, (i >= j0 + 1) ? a[1] : 0.f); w.y = pk2((i >= j0 + 2) ? a[2] : 0.f, (i >= j0 + 3) ? a[3] : 0.f);
            *(LAS v2u*)(lds + RT_P + i * RT_PS + j0 * 2) = w; }
        __builtin_amdgcn_sched_barrier(0);
        f32x16 part;
#pragma unroll
        for (int pass = 0; pass < 2; ++pass) { const int it = (pass == 0) ? (1 - dh) : dh;
            part = f32x16{};
#pragma unroll
            for (int dt = 0; dt < 4; ++dt)
#pragma unroll
                for (int s2 = 0; s2 < 2; ++s2) { const bf16x8 rb = pack8(R[dt], s2); const int dcol = 128 * dh + 32 * dt + 16 * s2 + 4 * hi;
                    const LAS unsigned char* qp = lds + RT_Q + (32 * it + r32) * RT_QS + dcol * 2;
                    const s16x4 lo = *(const LAS s16x4*)qp, hh = *(const LAS s16x4*)(qp + 16);
                    part = MFMA32(cat44(lo, hh), rb, part); }
            if (pass == 0) { LAS float* xo = (LAS float*)(lds + RT_X + wid * 4096);
#pragma unroll
                for (int r = 0; r < 16; ++r) xo[r * 64 + lane] = part[r];
                __builtin_amdgcn_sched_barrier(0); } }
        __syncthreads();
        const unsigned trb0 = tr_base(lane, 0), trb1 = tr_base(lane, 1);
        bf16x8 vf[4];
#pragma unroll
        for (int ks = 0; ks < 4; ++ks) vf[ks] = cat44(vtr(lds + RT_V + trb0 + 512 * ec + 4096 * ks), vtr(lds + RT_V + trb1 + 512 * ec + 4096 * ks));
        __builtin_amdgcn_sched_barrier(0);
        f32x16 oi = f32x16{};
#pragma unroll
        for (int jt = 0; jt < 2; ++jt) if (jt <= dh) {
#pragma unroll
            for (int s2 = 0; s2 < 2; ++s2) { const bf16x8 pa = *(const LAS bf16x8*)(lds + RT_P + (32 * dh + r32) * RT_PS + (32 * jt + 16 * s2 + 8 * hi) * 2);
                oi = MFMA32(pa, vf[2 * jt + s2], oi); } }
        __builtin_amdgcn_sched_barrier(0);
        {   const LAS float* xi = (const LAS float*)(lds + RT_X + (wid ^ 4) * 4096);
            LAS unsigned short* stg = (LAS unsigned short*)(lds + RT_O + wid * 2048);
#pragma unroll
            for (int r = 0; r < 16; ++r) {
                const float inter = part[r] + xi[r * 64 + lane];
                const float v = oi[r] + gam * inter;
                stg[crow(r, hi) * 32 + r32] = (unsigned short)f2bf(v); }
        }
        __builtin_amdgcn_sched_barrier(0);
#pragma unroll
        for (int dt = 0; dt < 4; ++dt)
#pragma unroll
            for (int r = 0; r < 16; ++r) R[dt][r] *= gam;
#pragma unroll
        for (int ks = 0; ks < 4; ++ks) { const LAS unsigned char* kb = lds + RT_K + dh * 16384;
            const bf16x8 vk = cat44(vtr(lds + RT_V + trb0 + 512 * ec + 4096 * ks), vtr(lds + RT_V + trb1 + 512 * ec + 4096 * ks));
#pragma unroll
            for (int dt = 0; dt < 4; ++dt) { const bf16x8 kf = cat44(vtr(kb + trb0 + 512 * dt + 4096 * ks), vtr(kb + trb1 + 512 * dt + 4096 * ks));
                R[dt] = MFMA32(kf, vk, R[dt]); } }
#pragma unroll
        for (int dt = 0; dt < 4; ++dt)
#pragma unroll
            for (int r = 0; r < 16; ++r) R[dt][r] *= gCm1;
        __syncthreads();
        if (step == ss0) ret_sample_unit(F, su0 >> 2, su0 & 3);
        if (step == ss1) ret_sample_unit(F, su1 >> 2, su1 & 3);
    }
    RT_FLUSH(NSTEP - 1);
#undef RT_FLUSH
#undef RT_ACC
    const int lane2 = lane_id();
    float* rp = F.out + O_RP + ((size_t)(b * 4 + h) * 256 + 128 * dh + 4 * (lane2 >> 5)) * 512 + es * 128 + ec * 32 + (lane2 & 31);
#pragma unroll
    for (int dt = 0; dt < 4; ++dt)
#pragma unroll
        for (int r = 0; r < 16; ++r) rp[(size_t)(32 * dt + (r & 3) + 8 * (r >> 2)) * 512] = R[dt][r];
#undef RT_LOAD
#undef RT_WRITE
}

constexpr int RS_Q = 0, RS_K = 1024, RS_RED = 2048, RS_ST = 2048 + 8192;
__device__ __forceinline__ void ret_sample_unit(Frame& F, int s, int h) {
    const int tid = cur_tid(F), lane = lane_id(), wid = F.wave;
    const bf16* Qr = (const bf16*)(F.ws + WS_Q); const bf16* Kr = Qr + (size_t)MPAD * DM; const bf16* Vr = (const bf16*)(F.ws + WS_SG); const bf16* SG2 = (const bf16*)(F.ws + WS_OG);
    bf16* OG2 = (bf16*)(F.ws + WS_ORAW);
    LAS float* qf = (LAS float*)(F.lds + RS_Q); LAS float* kf = (LAS float*)(F.lds + RS_K); LAS float* red = (LAS float*)(F.lds + RS_RED); LAS float* stt = (LAS float*)(F.lds + RS_ST);
    const size_t row = (size_t)MPR + s;
    const float gamma = 1.0f - exp2f(-5.0f - (float)h);
    if (tid < 256) { qf[tid] = bf2f(Qr[row * DM + h * 256 + tid]); kf[tid] = bf2f(Kr[row * DM + h * 256 + tid]); }
    __syncthreads();
    float qk = 0.f;
#pragma unroll
    for (int i = 0; i < 4; ++i) qk += qf[lane + 64 * i] * kf[lane + 64 * i];
    qk = wave_sum(qk);
    const int e4 = tid & 127, dg = tid >> 7;
    const v2u vw = *(const GAS v2u*)(Vr + row * AW + h * 512 + e4 * 4);
    const f32x4 v = {bflo(vw.x), bfhi(vw.x), bflo(vw.y), bfhi(vw.y)};
    const float* Rin = F.st + ((size_t)(s * 4 + h) * 256) * 512 + e4 * 4; float* Rout = F.out + O_RS + ((size_t)(s * 4 + h) * 256) * 512 + e4 * 4;
    f32x4 acc = {0.f, 0.f, 0.f, 0.f};
#pragma unroll 8
    for (int i = 0; i < 64; ++i) { const int d = dg + 4 * i; const f32x4 r = *(const GAS f32x4*)(Rin + (size_t)d * 512);
        const float kd = kf[d], qd = qf[d];
        *(GAS f32x4*)(Rout + (size_t)d * 512) = r * gamma + v * kd; acc += r * qd; }
    *(LAS f32x4*)(red + dg * 512 + e4 * 4) = acc;
    __syncthreads();
    float o[4] = {0.f, 0.f, 0.f, 0.f}; float sm = 0.f, s2m = 0.f;
    if (tid < 128) {
        const f32x4 t0 = *(const LAS f32x4*)(red + e4 * 4), t1 = *(const LAS f32x4*)(red + 512 + e4 * 4), t2 = *(const LAS f32x4*)(red + 1024 + e4 * 4), t3 = *(const LAS f32x4*)(red + 1536 + e4 * 4);
#pragma unroll
        for (int j = 0; j < 4; ++j) { o[j] = qk * v[j] + gamma * ((t0[j] + t1[j]) + (t2[j] + t3[j])); sm += o[j]; s2m += o[j] * o[j]; }
        sm = wave_sum(sm); s2m = wave_sum(s2m);
        if (lane == 0) { stt[wid * 2] = sm; stt[wid * 2 + 1] = s2m; }
    }
    __syncthreads();
    if (tid < 128) {
        const float S = stt[0] + stt[2], S2 = stt[1] + stt[3]; const float mu = S * (1.f / 512.f), var = fmaxf(S2 * (1.f / 512.f) - mu * mu, 0.f), rstd = 1.0f / sqrtf(var + EPS);
        const size_t gi = row * AW + h * 512 + e4 * 4; const v2u gw = *(const GAS v2u*)(SG2 + gi);
        v2u w; w.x = pk2((o[0] - mu) * rstd * bflo(gw.x), (o[1] - mu) * rstd * bfhi(gw.x)); w.y = pk2((o[2] - mu) * rstd * bflo(gw.y), (o[3] - mu) * rstd * bfhi(gw.y));
        *(GAS v2u*)(OG2 + gi) = w;
    }
    __syncthreads();
}
__device__ __forceinline__ void p5_retention(Frame& F) {
    if (F.G == 256) {
        const int v = F.vcu;
        ret_prompt_unit(F, v >> 4, (v >> 2) & 3, v & 3, v, (5 * v) & 31, v + 256, (5 * v + 16) & 31);
    } else {
        for (int u = F.vcu; u < 256; u += F.G) ret_prompt_unit(F, u >> 4, (u >> 2) & 3, u & 3, 0, -1, 0, -1);
        for (int u = F.vcu; u < NS * 4; u += F.G) ret_sample_unit(F, u >> 2, u & 3);
    }
}
__device__ __forceinline__ void p5b_normalize(Frame& F) {
    const int gw = F.vcu * NWAVES + F.wave, NGW = F.G * NWAVES, lane = lane_id();
    bf16* ORAW = (bf16*)(F.ws + WS_ORAW); const bf16* SG2 = (const bf16*)(F.ws + WS_OG); const float* STAT = (const float*)(F.ws + WS_STAT);
    for (int m = gw; m < MPR; m += NGW) {
#pragma unroll
        for (int hh = 0; hh < 4; ++hh) {
            const GAS f32x4* sp = (const GAS f32x4*)(STAT + ((size_t)m * 4 + hh) * 32); float S = 0.f, S2 = 0.f;
#pragma unroll
            for (int i = 0; i < 8; ++i) { const f32x4 t = sp[i]; S += t[0] + t[2]; S2 += t[1] + t[3]; }
            const float mu = S * (1.f / 512.f), var = fmaxf(S2 * (1.f / 512.f) - mu * mu, 0.f), rstd = 1.0f / sqrtf(var + EPS);
            const size_t gi = (size_t)m * AW + hh * 512 + lane * 8; const v4u ov = *(const GAS v4u*)(ORAW + gi), gv = *(const GAS v4u*)(SG2 + gi); v4u w;
#define NRM(o_, g_) pk2((bflo(o_) - mu) * rstd * bflo(g_), (bfhi(o_) - mu) * rstd * bfhi(g_))
            w.x = NRM(ov.x, gv.x); w.y = NRM(ov.y, gv.y); w.z = NRM(ov.z, gv.z); w.w = NRM(ov.w, gv.w);
#undef NRM
            *(GAS v4u*)(ORAW + gi) = w; }
    }
}
__device__ __forceinline__ void p7_final_norm(Frame& F) {
    const int gw = F.vcu * NWAVES + F.wave, NGW = F.G * NWAVES, lane = lane_id();
    for (int m = gw; m < MV; m += NGW) {
        float* rowp = (m < MPR) ? F.out + O_YP + (size_t)m * DM : F.out + O_YS + (size_t)(m - MPR) * DM;
        GAS f32x4* xr = (GAS f32x4*)rowp + lane; const GAS f32x4* gr = (const GAS f32x4*)F.fg + lane;
        f32x4 v[4]; float s = 0.f;
#pragma unroll
        for (int j = 0; j < 4; ++j) { v[j] = xr[64 * j]; s += (v[j].x * v[j].x + v[j].y * v[j].y) + (v[j].z * v[j].z + v[j].w * v[j].w); }
        const float rstd = 1.0f / sqrtf(wave_sum(s) * (1.f / DM) + EPS);
#pragma unroll
        for (int j = 0; j < 4; ++j) xr[64 * j] = v[j] * rstd * gr[64 * j];
    }
}

template <int K>
__device__ __forceinline__ void sgemm_unit(const bf16* A, int lda, const bf16* Bt, int n0, int n1, int wave, int lane, f32x4& c0, f32x4& c1) {
    const int l15 = lane & 15, g = lane >> 4;
    const bf16* ap = A + (size_t)(16 * wave + l15) * lda + 8 * g;
    const bf16* b0 = Bt + (size_t)(n0 + l15) * K + 8 * g; const bf16* b1 = Bt + (size_t)(n1 + l15) * K + 8 * g;
    c0 = f32x4{0.f, 0.f, 0.f, 0.f}; c1 = f32x4{0.f, 0.f, 0.f, 0.f};
#pragma unroll 8
    for (int s = 0; s < K / 32; ++s) { const bf16x8 a = *(const GAS bf16x8*)(ap + 32 * s), x = *(const GAS bf16x8*)(b0 + 32 * s), y = *(const GAS bf16x8*)(b1 + 32 * s);
        c0 = MFMA16(a, x, c0); c1 = MFMA16(a, y, c1); }
}
__device__ __forceinline__ void p1_sample(Frame& F) {
    const int lane = lane_id(), l15 = lane & 15, g = lane >> 4;
    const bf16* XN = (const bf16*)(F.ws + WS_XN) + (size_t)MPR * DM; const bf16* W = (const bf16*)(F.ws + WS_WINA);
    bf16* Q = (bf16*)(F.ws + WS_Q); bf16* SG = (bf16*)(F.ws + WS_SG);
    for (int u = F.vcu; u < ATT_IN / 32; u += F.G) { f32x4 c[2]; const int n0 = 32 * u;
        sgemm_unit<DM>(XN, DM, W, n0, n0 + 16, F.wave, lane, c[0], c[1]);
#pragma unroll
        for (int t = 0; t < 2; ++t) { const int col = n0 + 16 * t + l15;
#pragma unroll
            for (int r = 0; r < 4; ++r) { const int s = 16 * F.wave + 4 * g + r; const float v = c[t][r]; const size_t row = (size_t)MPR + s;
                if (col < 2048) Q[row * AW + col] = (unsigned short)f2bf(v * C2);
                else if (col < 2304) F.out[O_KS + (size_t)(s * 128 + 127) * 256 + (col - 2048)] = v;
                else if (col < 2560) F.out[O_VS + (size_t)(s * 128 + 127) * 256 + (col - 2304)] = v;
                else SG[row * AW + (col - 2560)] = (unsigned short)f2bf(silu_f(v)); } } }
}
__device__ __forceinline__ void p3_sample(Frame& F) {
    const int lane = lane_id(), l15 = lane & 15, g = lane >> 4;
    const bf16* OG = (const bf16*)(F.ws + WS_OG) + (size_t)MPR * AW; const bf16* W = (const bf16*)(F.ws + WS_WOA);
    float* X1 = (float*)(F.ws + WS_X1); bf16* XN2 = (bf16*)(F.ws + WS_XN); float* SSQS = (float*)(F.ws + WS_SSQ1) + (size_t)MPR * 16;
    for (int u = F.vcu; u < DM / 32; u += F.G) { f32x4 c[2]; const int n0 = 32 * u;
        sgemm_unit<AW>(OG, AW, W, n0, n0 + 16, F.wave, lane, c[0], c[1]);
#pragma unroll
        for (int t = 0; t < 2; ++t) { const int col = n0 + 16 * t + l15;
#pragma unroll
            for (int r = 0; r < 4; ++r) { const int s = 16 * F.wave + 4 * g + r; const size_t row = (size_t)MPR + s;
                const float x1 = F.xs[(size_t)s * DM + col] + c[t][r]; X1[row * DM + col] = x1; XN2[row * DM + col] = (unsigned short)f2bf(x1);
                float sq = x1 * x1; sq += __shfl_xor(sq, 1); sq += __shfl_xor(sq, 2); sq += __shfl_xor(sq, 4); sq += __shfl_xor(sq, 8);
                if (l15 == 0) SSQS[s * 64 + 2 * u + t] = sq; } } }
}
__device__ __forceinline__ void p4_sample(Frame& F) {
    const int lane = lane_id(), l15 = lane & 15, g = lane >> 4;
    const bf16* XN2 = (const bf16*)(F.ws + WS_XN) + (size_t)MPR * DM; const bf16* W = (const bf16*)(F.ws + WS_WINR);
    const float* SSQS = (const float*)(F.ws + WS_SSQ1) + (size_t)MPR * 16; const float* COS = (const float*)(F.ws + WS_COS) + 2048 * 128; const float* SIN = (const float*)(F.ws + WS_SIN) + 2048 * 128;
    bf16* Qr = (bf16*)(F.ws + WS_Q); bf16* Kr = Qr + (size_t)MPAD * DM; bf16* Vr = (bf16*)(F.ws + WS_SG); bf16* SG2 = (bf16*)(F.ws + WS_OG);
    for (int u = F.vcu; u < 192; u += F.G) {
        float rstd[4];
#pragma unroll
        for (int r = 0; r < 4; ++r) { const int s = 16 * F.wave + 4 * g + r; const GAS f32x4* sp = (const GAS f32x4*)(SSQS + s * 64) + (l15 & 3) * 4; float a = 0.f;
#pragma unroll
            for (int i = 0; i < 4; ++i) { const f32x4 t = sp[i]; a += (t[0] + t[1]) + (t[2] + t[3]); }
            a += __shfl_xor(a, 1); a += __shfl_xor(a, 2); rstd[r] = 1.0f / sqrtf(a * (1.f / DM) + EPS); }
        f32x4 c0, c1;
        if (u < 64) { const int hq = u >> 3, j = u & 7, n0 = 256 * hq + 16 * j, d = 16 * j + l15;
            sgemm_unit<DM>(XN2, DM, W, n0, n0 + 128, F.wave, lane, c0, c1);
            const float cc = COS[d], ss = SIN[d], sc = (hq < 4) ? 1.0f : 0.0625f; bf16* dst = (hq < 4) ? Qr : Kr;
#pragma unroll
            for (int r = 0; r < 4; ++r) { const int s = 16 * F.wave + 4 * g + r; const size_t row = (size_t)MPR + s; const float x1 = c0[r] * rstd[r] * sc, x2 = c1[r] * rstd[r] * sc;
                dst[row * DM + (hq & 3) * 256 + d] = (unsigned short)f2bf(x1 * cc - x2 * ss); dst[row * DM + (hq & 3) * 256 + 128 + d] = (unsigned short)f2bf(x1 * ss + x2 * cc); }
        } else { const int n0 = 2048 + 32 * (u - 64);
            sgemm_unit<DM>(XN2, DM, W, n0, n0 + 16, F.wave, lane, c0, c1);
#pragma unroll
            for (int t = 0; t < 2; ++t) { const int col = n0 + 16 * t + l15;
#pragma unroll
                for (int r = 0; r < 4; ++r) { const int s = 16 * F.wave + 4 * g + r; const size_t row = (size_t)MPR + s; const float v = (t == 0 ? c0[r] : c1[r]) * rstd[r];
                    if (col < 4096) Vr[row * AW + (col - 2048)] = (unsigned short)f2bf(v); else SG2[row * AW + (col - 4096)] = (unsigned short)f2bf(silu_f(v)); } } }
    }
}
__device__ __forceinline__ void p6_sample(Frame& F) {
    const int lane = lane_id(), l15 = lane & 15, g = lane >> 4;
    const bf16* OG2 = (const bf16*)(F.ws + WS_ORAW) + (size_t)MPR * AW; const bf16* W = (const bf16*)(F.ws + WS_WOR); const float* X1 = (const float*)(F.ws + WS_X1);
    for (int u = F.vcu; u < DM / 32; u += F.G) { f32x4 c[2]; const int n0 = 32 * u;
        sgemm_unit<AW>(OG2, AW, W, n0, n0 + 16, F.wave, lane, c[0], c[1]);
#pragma unroll
        for (int t = 0; t < 2; ++t) { const int col = n0 + 16 * t + l15;
#pragma unroll
            for (int r = 0; r < 4; ++r) { const int s = 16 * F.wave + 4 * g + r; F.out[O_YS + (size_t)s * DM + col] = X1[((size_t)MPR + s) * DM + col] + c[t][r]; } } }
}

__device__ __forceinline__ void grid_bar(const Frame& F, unsigned* cnt, unsigned target) {
    asm volatile("s_waitcnt vmcnt(0)" ::: "memory");
    __syncthreads();
    if (cur_tid(F) == 0) {
        __builtin_amdgcn_fence(__ATOMIC_RELEASE, "agent");
        asm volatile("s_waitcnt vmcnt(0)" ::: "memory");
        __hip_atomic_fetch_add(cnt, 1u, __ATOMIC_RELAXED, __HIP_MEMORY_SCOPE_AGENT);
        unsigned spins = 0;
        while (__hip_atomic_load(cnt, __ATOMIC_RELAXED, __HIP_MEMORY_SCOPE_AGENT) < target) { __builtin_amdgcn_s_sleep(2); if (++spins > (1u << 22)) break; }
        __builtin_amdgcn_fence(__ATOMIC_ACQUIRE, "agent");
        asm volatile("s_waitcnt vmcnt(0)" ::: "memory");
    }
    __syncthreads();
}
__global__ void __launch_bounds__(NTHR, 2) fwd_kernel(Args args) {
    extern __shared__ __attribute__((aligned(16))) unsigned char lds[];
    cg::grid_group grid = cg::this_grid();
    Frame F;
    F.lds = (LAS unsigned char*)lds;
    F.wave = __builtin_amdgcn_readfirstlane((int)threadIdx.x >> 6);
    F.G = gridDim.x; { const int bx = blockIdx.x; F.vcu = (F.G % 8 == 0) ? (bx % 8) * (F.G / 8) + bx / 8 : bx; }
    F.xp = args.in[0]; F.xs = args.in[1]; F.ck = args.in[2]; F.cv = args.in[3]; F.st = args.in[4]; F.ng = args.in[5]; F.fg = args.in[6]; F.rb = args.in[7];
    F.wia = args.in[8]; F.sk = args.in[9]; F.woa = args.in[10]; F.wir = args.in[11]; F.wor = args.in[12];
    F.out = args.out; F.ws = args.ws;
    const int lo = args.ph_lo, hi = args.ph_hi;
#ifndef DUP_MASK
#define DUP_MASK 0
#endif
#define REP(k) for (int rep_ = 0; rep_ < 1 + ((DUP_MASK >> (k)) & 1) * DUP_N; ++rep_)
#ifndef DUP_N
#define DUP_N 1
#endif
#ifndef PH_MASK
#define PH_MASK 0x1ff
#endif
#define IN(k) (((PH_MASK >> (k)) & 1) && lo <= (k) && (k) < hi)
#define SEAM(k) do { if (IN(k) && IN((k) + 1)) { if ((k) == 0) grid.sync(); else grid_bar(F, bar_cnt, (unsigned)(k) * (unsigned)F.G); } } while (0)
    unsigned* bar_cnt = (unsigned*)(F.ws + 256);
    if (IN(0) && blockIdx.x == 0 && cur_tid(F) == 0) __hip_atomic_store(bar_cnt, 0u, __ATOMIC_RELAXED, __HIP_MEMORY_SCOPE_AGENT);

    if (IN(0)) REP(0) { p0_prologue(F); }
    SEAM(0);
    if (IN(1)) REP(1) {
        pg8::Gemm g{(const pg8::bf16_t*)(F.ws + WS_XN), (const pg8::bf16_t*)(F.ws + WS_WINA), MPR, ATT_IN, DM};
        pg8::StaticOrder S; S.init(MPR, ATT_IN, F.G, (int)blockIdx.x);
        EpiAttnIn E{(bf16*)(F.ws + WS_Q), (bf16*)(F.ws + WS_K), (bf16*)(F.ws + WS_V), (bf16*)(F.ws + WS_SG), F.out};
        pg8::gemm_phase<EpiAttnIn, pg8::StaticOrder, true, true>(F.lds, g, S, E, F.wave);
        p1_sample(F);
    }
    SEAM(1);
    if (IN(2)) REP(2) { p2_attention(F); }
    SEAM(2);
    if (IN(3)) REP(3) {
        pg8::Gemm g{(const pg8::bf16_t*)(F.ws + WS_OG), (const pg8::bf16_t*)(F.ws + WS_WOA), MPR, DM, AW};
        pg8::StaticOrder S; S.init(MPR, DM, F.G, (int)blockIdx.x);
        EpiOutRes E{F.xp, (bf16*)(F.ws + WS_XN), (float*)(F.ws + WS_SSQ1)};
        pg8::gemm_phase<EpiOutRes, pg8::StaticOrder, true, true>(F.lds, g, S, E, F.wave);
        p3_sample(F);
    }
    SEAM(3);
    if (IN(4)) REP(4) {
        pg8::Gemm g{(const pg8::bf16_t*)(F.ws + WS_XN), (const pg8::bf16_t*)(F.ws + WS_WINR), MPR, RET_IN, DM};
        pg8::StaticOrder S; S.init(MPR, RET_IN, F.G, (int)blockIdx.x);
        EpiRetIn E{(const float*)(F.ws + WS_SSQ1), (const float*)(F.ws + WS_COS), (const float*)(F.ws + WS_SIN), (bf16*)(F.ws + WS_Q), (bf16*)(F.ws + WS_Q) + (size_t)MPAD * DM, (bf16*)(F.ws + WS_SG), (bf16*)(F.ws + WS_OG)};
        pg8::gemm_phase<EpiRetIn, pg8::StaticOrder, true, true>(F.lds, g, S, E, F.wave);
        p4_sample(F);
    }
    SEAM(4);
    if (IN(5)) REP(5) { p5_retention(F); }
    SEAM(5);
    if (IN(6)) REP(6) { p5b_normalize(F); }
    SEAM(6);
    if (IN(7)) REP(7) {
        pg8::Gemm g{(const pg8::bf16_t*)(F.ws + WS_ORAW), (const pg8::bf16_t*)(F.ws + WS_WOR), MPR, DM, AW};
        pg8::StaticOrder S; S.init(MPR, DM, F.G, (int)blockIdx.x);
        EpiOutFinal E{(const bf16*)(F.ws + WS_XN), F.out};
        pg8::gemm_phase<EpiOutFinal, pg8::StaticOrder, true, true>(F.lds, g, S, E, F.wave);
        p6_sample(F);
    }
    SEAM(7);
    if (IN(8)) REP(8) { p7_final_norm(F); }
#undef IN
#undef SEAM
}

extern "C" void kernel_launch(void* const* d_in, const int* in_sizes, int n_in, void* d_out, int out_size, void* d_ws, size_t ws_size, hipStream_t stream) {
    static int grid = 0;
    if (grid == 0) {
        if (n_in != 13 || (size_t)out_size != O_END || ws_size < WS_END) { fprintf(stderr, "kernel_launch: unexpected shapes: n_in %d out %d ws %zu\n", n_in, out_size, ws_size); grid = -1; return; }
        int dev = 0, cus = 0, per_cu = 0;
        (void)hipGetDevice(&dev); (void)hipDeviceGetAttribute(&cus, hipDeviceAttributeMultiprocessorCount, dev);
        (void)hipFuncSetAttribute((const void*)fwd_kernel, hipFuncAttributeMaxDynamicSharedMemorySize, LDS_BYTES);
        (void)hipOccupancyMaxActiveBlocksPerMultiprocessor(&per_cu, (const void*)fwd_kernel, NTHR, LDS_BYTES);
        if (per_cu < 1) { fprintf(stderr, "kernel_launch: occupancy query says %d blocks per CU\n", per_cu); per_cu = 1; }
        (void)hipGetLastError();
        grid = cus;
        fprintf(stderr, "kernel_launch: cus %d per_cu %d grid %d\n", cus, per_cu, grid);
    }
    if (grid < 0) return;
    Args a{};
    for (int i = 0; i < 13; ++i) a.in[i] = (const float*)d_in[i];
    a.out = (float*)d_out; a.ws = (unsigned char*)d_ws; a.ph_lo = 0; a.ph_hi = 9;
    void* kargs[] = {&a};
    hipError_t e = hipLaunchCooperativeKernel((const void*)fwd_kernel, dim3(grid), dim3(NTHR), kargs, LDS_BYTES, stream);
    if (e != hipSuccess) fprintf(stderr, "kernel_launch: cooperative launch failed: %s (grid %d)\n", hipGetErrorString(e), grid);
}
```
